# Optimizing an MI355X kernel written in HIP

```python
import jax, jax.numpy as jnp
from jax import lax
import numpy as np

D_MODEL = 1024
BATCH = 8
SEQ = 8192
DEPTH = 2
DEC_BATCH = 32
DEC_SEQ = 32
PAST_LEN = 4096

CHUNK = 64
N_META = 16
N_HEADS = 8
D_NOPE = 64
D_ROPE = 32
D_QK = D_NOPE + D_ROPE
D_V = 64
Q_RANK = 384
KV_RANK = 256
ATTN_WIDTH = N_HEADS * D_V
POOL_WIDTH = D_MODEL - ATTN_WIDTH
POOL_WINDOWS = (2, 4, 8, 16)
N_POOL_GROUPS = len(POOL_WINDOWS)
POOL_GROUP = POOL_WIDTH // N_POOL_GROUPS
POOL_STATE = max(POOL_WINDOWS) - 1
D_IN = POOL_WIDTH + Q_RANK + KV_RANK + D_ROPE
D_FF = ((8 * D_MODEL + 2) // 3 + 255) // 256 * 256
ROPE_THETA = 10000.0
EPS = 1e-6
Q_BLOCK = 128

kernel_name = 'hybrid_pool_mla_stream_step'


def rms_norm(x, g):
    xf = x.astype(jnp.float32)
    y = xf * lax.rsqrt(jnp.mean(xf * xf, axis=-1, keepdims=True) + EPS)
    return (y * g.astype(jnp.float32)).astype(x.dtype)


def rope(x, pos):
    half = D_ROPE // 2
    inv = ROPE_THETA ** (-jnp.arange(half, dtype=jnp.float32) / half)
    ang = pos.astype(jnp.float32)[:, None] * inv[None, :]
    shape = (ang.shape[0],) + (1,) * (x.ndim - 3) + (half,)
    cos = jnp.cos(ang).reshape(shape)
    sin = jnp.sin(ang).reshape(shape)
    xf = x.astype(jnp.float32)
    x1, x2 = xf[..., :half], xf[..., half:]
    return jnp.concatenate([x1 * cos - x2 * sin, x1 * sin + x2 * cos], axis=-1).astype(x.dtype)


def pool_mix(u_ext, n_prev, w_pool, pool_scale):
    B, L, _ = u_ext.shape
    T = L - n_prev
    uf = u_ext.astype(jnp.float32)
    csum = jnp.concatenate([jnp.zeros((B, 1, POOL_WIDTH), jnp.float32), jnp.cumsum(uf, axis=1)], axis=1)
    t = jnp.arange(n_prev, L)
    means = []
    for g, w in enumerate(POOL_WINDOWS):
        sl = slice(g * POOL_GROUP, (g + 1) * POOL_GROUP)
        lo = jnp.maximum(t + 1 - w, 0)
        cnt = jnp.minimum(t + 1, w).astype(jnp.float32)
        means.append((csum[:, t + 1, sl] - csum[:, lo, sl]) / cnt[None, :, None])
    d = (jnp.concatenate(means, axis=-1) - uf[:, n_prev:]).reshape(B, T, N_POOL_GROUPS, POOL_GROUP)
    y = jnp.einsum('btgc,gcd->btgd', d, w_pool.astype(jnp.float32)).reshape(B, T, POOL_WIDTH)
    return (y * pool_scale.astype(jnp.float32)).astype(u_ext.dtype)


def block_causal_attention(q, k, v, q_chunk, k_chunk):
    scale = D_QK ** -0.5

    def attend(qb, qc):
        s = jnp.einsum('bqhd,bkhd->bhqk', qb, k, preferred_element_type=jnp.float32) * scale
        mask = qc[:, None] >= k_chunk[None, :]
        s = jnp.where(mask[None, None], s, -jnp.inf)
        p = jax.nn.softmax(s, axis=-1)
        return jnp.einsum('bhqk,bkhd->bqhd', p.astype(v.dtype), v)

    B, Lq, H, D = q.shape
    if Lq <= Q_BLOCK:
        return attend(q, q_chunk)
    nb = -(-Lq // Q_BLOCK)
    pad = nb * Q_BLOCK - Lq
    qp = jnp.pad(q, ((0, 0), (0, pad), (0, 0), (0, 0)))
    cp = jnp.pad(q_chunk, (0, pad), mode='edge')
    qb = qp.reshape(B, nb, Q_BLOCK, H, D).transpose(1, 0, 2, 3, 4)
    cb = cp.reshape(nb, Q_BLOCK)
    out = lax.map(lambda a: attend(a[0], a[1]), (qb, cb))
    out = out.transpose(1, 0, 2, 3, 4).reshape(B, nb * Q_BLOCK, H, D_V)
    return out[:, :Lq]


def mixer(h, pos, q_chunk, k_chunk, past_lat, past_kpe, past_pool,
          w_in, q_a_norm, w_uq, kv_a_norm, w_uk, w_uv, q_norm, k_norm, w_pool, pool_scale, w_o):
    B, T, _ = h.shape
    z = h @ w_in
    u, q_lat, kv_lat, k_pe = jnp.split(z, [POOL_WIDTH, POOL_WIDTH + Q_RANK, POOL_WIDTH + Q_RANK + KV_RANK], axis=-1)
    u_ext = jnp.concatenate([past_pool.astype(u.dtype), u], axis=1)
    pool_out = pool_mix(u_ext, u_ext.shape[1] - T, w_pool, pool_scale)
    new_pool = u_ext[:, -POOL_STATE:]
    q = (rms_norm(q_lat, q_a_norm) @ w_uq).reshape(B, T, N_HEADS, D_QK)
    q = rms_norm(jnp.concatenate([q[..., :D_NOPE], rope(q[..., D_NOPE:], pos)], axis=-1), q_norm)
    c_kv = rms_norm(kv_lat, kv_a_norm)
    k_pe = rope(k_pe, pos)
    lat_all = jnp.concatenate([past_lat.astype(c_kv.dtype), c_kv], axis=1)
    kpe_all = jnp.concatenate([past_kpe.astype(k_pe.dtype), k_pe], axis=1)
    Lk = lat_all.shape[1]
    k_nope = (lat_all @ w_uk).reshape(B, Lk, N_HEADS, D_NOPE)
    v = (lat_all @ w_uv).reshape(B, Lk, N_HEADS, D_V)
    k = jnp.concatenate([k_nope, jnp.broadcast_to(kpe_all[:, :, None, :], (B, Lk, N_HEADS, D_ROPE))], axis=-1)
    k = rms_norm(k, k_norm)
    attn = block_causal_attention(q, k, v, q_chunk, k_chunk).reshape(B, T, ATTN_WIDTH)
    y = jnp.concatenate([pool_out, attn], axis=-1) @ w_o
    return y, c_kv, k_pe, new_pool


def swiglu(h, w_gate, w_up, w_down):
    return (jax.nn.silu(h @ w_gate) * (h @ w_up)) @ w_down


def trunk(x, pos, q_chunk, k_chunk, past_lat, past_kpe, past_pool, weights):
    (norm_mix, w_in, q_a_norm, w_uq, kv_a_norm, w_uk, w_uv, q_norm, k_norm,
     w_pool, pool_scale, w_o, norm_ffn, w_gate, w_up, w_down) = weights
    lat_rows, kpe_rows, pool_rows = [], [], []
    for l in range(DEPTH):
        y, c_kv, k_pe, new_pool = mixer(
            rms_norm(x, norm_mix[l]), pos, q_chunk, k_chunk, past_lat[l], past_kpe[l], past_pool[l],
            w_in[l], q_a_norm[l], w_uq[l], kv_a_norm[l], w_uk[l], w_uv[l], q_norm[l], k_norm[l],
            w_pool[l], pool_scale[l], w_o[l])
        x = x + y
        x = x + swiglu(rms_norm(x, norm_ffn[l]), w_gate[l], w_up[l], w_down[l])
        lat_rows.append(c_kv)
        kpe_rows.append(k_pe)
        pool_rows.append(new_pool)
    return x, jnp.stack(lat_rows), jnp.stack(kpe_rows), jnp.stack(pool_rows)


def setup_inputs(seed: int = 0) -> dict:
    key = jax.random.key(seed)
    ks = jax.random.split(key, 22)
    f32 = jnp.float32

    def normal(k, shape):
        return jax.random.normal(k, shape, f32)

    def dense(k, shape, fan_in):
        return jax.random.normal(k, shape, f32) * fan_in ** -0.5

    def gain(k, shape):
        return 1.0 + 0.05 * jax.random.normal(k, shape, f32)

    return {
        'x_prompt': normal(ks[0], (BATCH, SEQ, D_MODEL)),
        'x_sample': normal(ks[1], (DEC_BATCH, DEC_SEQ, D_MODEL)),
        'cache_latent': normal(ks[2], (DEPTH, DEC_BATCH, N_META + PAST_LEN, KV_RANK)),
        'cache_krope': normal(ks[3], (DEPTH, DEC_BATCH, N_META + PAST_LEN, D_ROPE)),
        'state_pool': normal(ks[4], (DEPTH, DEC_BATCH, POOL_STATE, POOL_WIDTH)),
        'meta_tokens': normal(ks[5], (N_META, D_MODEL)),
        'norm_mix': gain(ks[6], (DEPTH, D_MODEL)),
        'w_in': dense(ks[7], (DEPTH, D_MODEL, D_IN), D_MODEL),
        'q_a_norm': gain(ks[8], (DEPTH, Q_RANK)),
        'w_uq': dense(ks[9], (DEPTH, Q_RANK, N_HEADS * D_QK), Q_RANK),
        'kv_a_norm': gain(ks[10], (DEPTH, KV_RANK)),
        'w_uk': dense(ks[11], (DEPTH, KV_RANK, N_HEADS * D_NOPE), KV_RANK),
        'w_uv': dense(ks[12], (DEPTH, KV_RANK, N_HEADS * D_V), KV_RANK),
        'q_norm': gain(ks[13], (DEPTH, D_QK)),
        'k_norm': gain(ks[14], (DEPTH, D_QK)),
        'w_pool': dense(ks[15], (DEPTH, N_POOL_GROUPS, POOL_GROUP, POOL_GROUP), POOL_GROUP),
        'pool_scale': gain(ks[16], (DEPTH, POOL_WIDTH)),
        'w_o': dense(ks[17], (DEPTH, D_MODEL, D_MODEL), D_MODEL),
        'norm_ffn': gain(ks[18], (DEPTH, D_MODEL)),
        'w_gate': dense(ks[19], (DEPTH, D_MODEL, D_FF), D_MODEL),
        'w_up': dense(ks[20], (DEPTH, D_MODEL, D_FF), D_MODEL),
        'w_down': dense(ks[21], (DEPTH, D_FF, D_MODEL), D_FF),
    }


def reference(x_prompt, x_sample, cache_latent, cache_krope, state_pool, meta_tokens,
              norm_mix, w_in, q_a_norm, w_uq, kv_a_norm, w_uk, w_uv, q_norm, k_norm,
              w_pool, pool_scale, w_o, norm_ffn, w_gate, w_up, w_down):
    weights = (norm_mix, w_in, q_a_norm, w_uq, kv_a_norm, w_uk, w_uv, q_norm, k_norm,
               w_pool, pool_scale, w_o, norm_ffn, w_gate, w_up, w_down)
    dt = x_prompt.dtype
    Bp, S, _ = x_prompt.shape
    meta = jnp.broadcast_to(meta_tokens.astype(dt)[None], (Bp, N_META, D_MODEL))
    xp = jnp.concatenate([meta, x_prompt], axis=1)
    pos_p = jnp.arange(N_META + S, dtype=jnp.int32)
    chunk_p = jnp.where(pos_p < N_META, -1, (pos_p - N_META) // CHUNK)
    empty_lat = jnp.zeros((DEPTH, Bp, 0, KV_RANK), dt)
    empty_kpe = jnp.zeros((DEPTH, Bp, 0, D_ROPE), dt)
    empty_pool = jnp.zeros((DEPTH, Bp, 0, POOL_WIDTH), dt)
    yp, lat_p, kpe_p, pool_p = trunk(xp, pos_p, chunk_p, chunk_p, empty_lat, empty_kpe, empty_pool, weights)
    y_prompt = yp[:, N_META:]
    T = x_sample.shape[1]
    past = cache_latent.shape[2] - N_META
    pos_s = N_META + past + jnp.arange(T, dtype=jnp.int32)
    k_idx = jnp.arange(N_META + past + T, dtype=jnp.int32)
    chunk_k = jnp.where(k_idx < N_META, -1, (k_idx - N_META) // CHUNK)
    chunk_q = (pos_s - N_META) // CHUNK
    y_sample, lat_s, kpe_s, pool_s = trunk(x_sample, pos_s, chunk_q, chunk_k,
                                           cache_latent, cache_krope, state_pool, weights)
    return (y_prompt, y_sample, lat_p, kpe_p, pool_p, lat_s, kpe_s, pool_s)
```

```cpp
#include <hip/hip_runtime.h>
#include <hip/hip_cooperative_groups.h>
#include <cstdio>
#include <cstdint>
namespace cg = cooperative_groups;

#define LAS __attribute__((address_space(3)))
typedef unsigned short bf16_t;
typedef short bf16x8 __attribute__((ext_vector_type(8)));
typedef float f32x4 __attribute__((ext_vector_type(4)));
typedef float f32x2 __attribute__((ext_vector_type(2)));
typedef float f32x16 __attribute__((ext_vector_type(16)));
typedef unsigned u32x4 __attribute__((ext_vector_type(4)));
typedef unsigned u32x2 __attribute__((ext_vector_type(2)));
typedef __bf16 bf16x2_t __attribute__((ext_vector_type(2)));

constexpr int D = 1024, NB = 8, SEQ = 8192, NMETA = 16, TP = SEQ + NMETA, MP = NB * TP;
constexpr int DB = 32, DS = 32, MS = DB * DS, M = MP + MS, MPAD = 66816;
constexpr int CROWS = 4112, SK = CROWS + DS, SKP = 4160;
constexpr int KR = MP + DB * SKP, KRPAD = 198912;
constexpr int DIN = 1184, DINP = 1280, QRK = 384, KVR = 256, DROPE = 32, NH = 8, DQK = 96, DNOPE = 64, DV = 64, DFF = 2816, PW = 512;
constexpr float EPS = 1e-6f;
static_assert(MPAD % 256 == 0 && MPAD >= M && KRPAD % 256 == 0 && KRPAD >= KR, "pad");

constexpr size_t W_IN = 0, W_UQ = W_IN + (size_t)DINP * D, W_UK = W_UQ + (size_t)768 * QRK, W_UV = W_UK + (size_t)512 * KVR, W_O = W_UV + (size_t)512 * KVR,
                 W_GU = W_O + (size_t)D * D, W_DN = W_GU + (size_t)2 * DFF * D, W_LAYER = W_DN + (size_t)D * DFF;
constexpr size_t WS_XRES = 0, WS_WTS = WS_XRES + (size_t)MPAD * D * 4, WS_MIX = WS_WTS + 2 * W_LAYER * 2, WS_HBUF = WS_MIX + (size_t)MPAD * D * 2,
                 WS_ACT = WS_HBUF + (size_t)MPAD * D * 2, WS_QRAW = WS_ACT + (size_t)MPAD * DFF * 2, WS_END = WS_QRAW + (size_t)MPAD * 768 * 2;
constexpr size_t WS_BAR = (WS_END + 255) / 256 * 256, WS_SSK = WS_BAR + 3456 * 4 + 256, WS_TOTAL = WS_SSK + (size_t)KRPAD * 4;
static_assert(WS_TOTAL <= (size_t)1 << 30, "workspace");
constexpr size_t WS_SLOT = WS_HBUF + (size_t)KRPAD * 256 * 2, WS_RS = WS_SLOT + (size_t)MPAD * 16 * 4;
static_assert(WS_RS + (size_t)MPAD * 4 <= WS_HBUF + (size_t)MPAD * D * 2, "lat + row stats fit hbuf");
static_assert((size_t)MPAD * DINP * 4 <= (size_t)MPAD * DFF * 2, "z fits act");
static_assert((size_t)KRPAD * 768 * 2 <= (size_t)MPAD * DFF * 2, "Kn+Kr fits act");
static_assert((size_t)KRPAD * 512 * 2 + (size_t)MPAD * QRK * 2 <= (size_t)NB * SEQ * D * 4, "Vt+qa fit y_prompt");
constexpr size_t O_YP = 0, O_YS = O_YP + (size_t)NB * SEQ * D, O_LATP = O_YS + (size_t)MS * D, O_KPEP = O_LATP + (size_t)2 * MP * KVR, O_POOLP = O_KPEP + (size_t)2 * MP * DROPE,
                 O_LATS = O_POOLP + (size_t)2 * NB * 15 * PW, O_KPES = O_LATS + (size_t)2 * MS * KVR, O_POOLS = O_KPES + (size_t)2 * MS * DROPE, O_END = O_POOLS + (size_t)2 * DB * 15 * PW;

__device__ const double INVF[16] = {1.0, 0.5623413251903491, 0.31622776601683794, 0.1778279410038923, 0.1, 0.05623413251903491, 0.03162277660168379, 0.01778279410038923,
                                    0.01, 0.005623413251903491, 0.0031622776601683794, 0.0017782794100389228, 0.001, 0.0005623413251903491, 0.00031622776601683794, 0.00017782794100389227};

struct Params {
    const float *x_prompt, *x_sample, *cache_latent, *cache_krope, *state_pool, *meta, *norm_mix, *w_in, *q_a_norm, *w_uq, *kv_a_norm, *w_uk, *w_uv, *q_norm, *k_norm,
        *w_pool, *pool_scale, *w_o, *norm_ffn, *w_gate, *w_up, *w_down;
    float* out; unsigned char* ws;
};

__device__ __forceinline__ unsigned pk2(float a, float b) { f32x2 v = {a, b}; bf16x2_t r = __builtin_convertvector(v, bf16x2_t); return __builtin_bit_cast(unsigned, r); }
__device__ __forceinline__ float bflo(unsigned u) { return __uint_as_float(u << 16); }
__device__ __forceinline__ float bfhi(unsigned u) { return __uint_as_float(u & 0xffff0000u); }
__device__ __forceinline__ f32x2 ld2(const bf16_t* p) { const unsigned u = *(const unsigned*)p; return (f32x2){bflo(u), bfhi(u)}; }
__device__ __forceinline__ f32x4 ld4(const bf16_t* p) { const u32x2 u = *(const u32x2*)p; return (f32x4){bflo(u.x), bfhi(u.x), bflo(u.y), bfhi(u.y)}; }
template <int MASK> __device__ __forceinline__ float shx(float v) {
    static_assert(MASK >= 1 && MASK < 32, "swizzle mask");
    return __int_as_float(__builtin_amdgcn_ds_swizzle(__float_as_int(v), 0x1f | (MASK << 10)));
}
__device__ __forceinline__ float shx32(float v, int lane) { return __int_as_float(__builtin_amdgcn_ds_bpermute((lane ^ 32) << 2, __float_as_int(v))); }
__device__ __forceinline__ float sum32(float v) { v += shx<1>(v); v += shx<2>(v); v += shx<4>(v); v += shx<8>(v); v += shx<16>(v); return v; }
__device__ __forceinline__ float wave_sum(float v, int lane) { v = sum32(v); return v + shx32(v, lane); }
__device__ __forceinline__ void rope_cs(int pos, int i, float& c, float& s) {
    const double rev = (double)pos * INVF[i] * 0.15915494309189535;
    const float fr = (float)(rev - floor(rev));
    c = __builtin_amdgcn_cosf(fr); s = __builtin_amdgcn_sinf(fr);
}

namespace pg8 {
constexpr int BM = 256, BK = 64, HALF = 128, HTB = HALF * BK * 2, STAGE_BYTES = 8 * HTB, NXCD = 8, WGM = 8;
__host__ __device__ __forceinline__ int lds_byte(int r, int c) { const int st = (r >> 4) * 2 + (c >> 5), rr = r & 15, cc = c & 31, ob = rr * 64 + cc * 2; return st * 1024 + (ob ^ (((ob >> 9) & 1) << 5)); }
__host__ __device__ __forceinline__ void stage_rc(int b, int& R, int& C) { const int st = b / 1024, sb = b % 1024, swz = sb ^ (((sb >> 9) & 1) << 5); R = (st >> 1) * 16 + swz / 64; C = (st & 1) * 32 + (swz % 64) / 2; }
__host__ __device__ __forceinline__ int perm32(int rho) { const int n = rho >> 4, i = rho & 15; return 8 * (i >> 2) + 4 * n + (i & 3); }
struct Unit { int pm, pn; };
struct Gemm { const bf16_t* A; const bf16_t* Bt; int M, N, K; };
struct StaticOrder {
    int nM, nN, nwg, G, c;
    __host__ __device__ void init(int M_, int N_, int G_, int c_) { nM = M_ / BM; nN = N_ / BM; nwg = nM * nN; G = G_; c = c_; }
    __host__ __device__ bool next(int i, Unit& u) const {
        const long L = (long)i * G + c; if (L >= nwg) return false;
        int wgid = (int)L; { const int q = nwg / NXCD, r = nwg % NXCD, xcd = wgid % NXCD, off = wgid / NXCD; wgid = (xcd < r ? xcd * (q + 1) : r * (q + 1) + (xcd - r) * q) + off; }
        const int nig = WGM * nN, gid = wgid / nig, fm = gid * WGM, gsz = (nM - fm) < WGM ? (nM - fm) : WGM;
        u.pm = fm + ((wgid % nig) % gsz); u.pn = (wgid % nig) / gsz; return true;
    }
    __device__ __forceinline__ void a_ready(const Unit&) const {}
    __device__ __forceinline__ void done(const Unit&) const {}
};
__device__ __forceinline__ unsigned cvt_pk_bf16(float lo, float hi) { unsigned r; asm volatile("v_cvt_pk_bf16_f32 %0, %1, %2" : "=v"(r) : "v"(lo), "v"(hi)); return r; }

struct EpiF32 {
    static constexpr bool PERM = false, AFTER_DRAIN = false;
    float* C; int ldc;
    __device__ __forceinline__ void operator()(const f32x4 (&acc)[2][2][4][2], const Unit& u, int wr, int wc, int fr, int fq) const {
        const int row0 = u.pm * BM + wr * 64 + fr, col0 = u.pn * BM + wc * 32 + 4 * fq;
#pragma unroll
        for (int ai = 0; ai < 2; ++ai)
#pragma unroll
            for (int m = 0; m < 4; ++m) { float* rowp = C + (size_t)(row0 + ai * HALF + m * 16) * ldc + col0;
#pragma unroll
                for (int bj = 0; bj < 2; ++bj)
#pragma unroll
                    for (int n = 0; n < 2; ++n) *(f32x4*)(rowp + bj * HALF + n * 16) = acc[ai][bj][m][n]; }
    }
};
struct EpiResAdd {
    static constexpr bool PERM = false, AFTER_DRAIN = false;
    float* C; int ldc;
    __device__ __forceinline__ void operator()(const f32x4 (&acc)[2][2][4][2], const Unit& u, int wr, int wc, int fr, int fq) const {
        const int row0 = u.pm * BM + wr * 64 + fr, col0 = u.pn * BM + wc * 32 + 4 * fq;
#pragma unroll
        for (int ai = 0; ai < 2; ++ai)
#pragma unroll
            for (int m = 0; m < 4; ++m) { float* rowp = C + (size_t)(row0 + ai * HALF + m * 16) * ldc + col0;
                f32x4 old[2][2];
#pragma unroll
                for (int bj = 0; bj < 2; ++bj)
#pragma unroll
                    for (int n = 0; n < 2; ++n) old[bj][n] = *(const f32x4*)(rowp + bj * HALF + n * 16);
#pragma unroll
                for (int bj = 0; bj < 2; ++bj)
#pragma unroll
                    for (int n = 0; n < 2; ++n) *(f32x4*)(rowp + bj * HALF + n * 16) = old[bj][n] + acc[ai][bj][m][n]; }
    }
};
struct EpiResInit {
    static constexpr bool PERM = false, AFTER_DRAIN = false;
    float* C; const float* meta; const float* xp; const float* xs;
    __device__ __forceinline__ void operator()(const f32x4 (&acc)[2][2][4][2], const Unit& u, int wr, int wc, int fr, int fq) const {
        const int row0 = u.pm * BM + wr * 64 + fr, col0 = u.pn * BM + wc * 32 + 4 * fq;
#pragma unroll
        for (int ai = 0; ai < 2; ++ai)
#pragma unroll
            for (int m = 0; m < 4; ++m) { const int r = row0 + ai * HALF + m * 16;
                if (r < M) {
                    const float* src;
                    if (r < MP) { const int b = r / TP, t = r - b * TP; src = (t < NMETA) ? meta + (size_t)t * D : xp + ((size_t)b * SEQ + (t - NMETA)) * D; }
                    else src = xs + (size_t)(r - MP) * D;
                    float* rowp = C + (size_t)r * D + col0; src += col0;
                    f32x4 old[2][2];
#pragma unroll
                    for (int bj = 0; bj < 2; ++bj)
#pragma unroll
                        for (int n = 0; n < 2; ++n) old[bj][n] = *(const f32x4*)(src + bj * HALF + n * 16);
#pragma unroll
                    for (int bj = 0; bj < 2; ++bj)
#pragma unroll
                        for (int n = 0; n < 2; ++n) *(f32x4*)(rowp + bj * HALF + n * 16) = old[bj][n] + acc[ai][bj][m][n];
                } }
    }
};
struct EpiFinal {
    static constexpr bool PERM = false, AFTER_DRAIN = false;
    const float* X; float* out;
    __device__ __forceinline__ void operator()(const f32x4 (&acc)[2][2][4][2], const Unit& u, int wr, int wc, int fr, int fq) const {
        const int row0 = u.pm * BM + wr * 64 + fr, col0 = u.pn * BM + wc * 32 + 4 * fq;
#pragma unroll
        for (int ai = 0; ai < 2; ++ai)
#pragma unroll
            for (int m = 0; m < 4; ++m) { const int r = row0 + ai * HALF + m * 16; float* dst = nullptr;
                if (r < MP) { const int b = r / TP, t = r - b * TP; if (t >= NMETA) dst = out + O_YP + ((size_t)b * SEQ + (t - NMETA)) * D; }
                else if (r < M) dst = out + O_YS + (size_t)(r - MP) * D;
                if (dst) { const float* xp = X + (size_t)r * D + col0;
#pragma unroll
                    for (int bj = 0; bj < 2; ++bj)
#pragma unroll
                        for (int n = 0; n < 2; ++n) *(f32x4*)(dst + col0 + bj * HALF + n * 16) = *(const f32x4*)(xp + bj * HALF + n * 16) + acc[ai][bj][m][n]; } }
    }
};
template <int LDC> struct EpiBf16S {
    static constexpr bool PERM = true, AFTER_DRAIN = false;
    static constexpr size_t ldc = LDC;
    bf16_t* O; const float* rs;
    __device__ __forceinline__ void operator()(const f32x4 (&acc)[2][2][4][2], const Unit& u, int wr, int wc, int fr, int fq) const {
        const int row0 = u.pm * BM + wr * 64 + fr, col0 = u.pn * BM + wc * 32 + 8 * fq;
        float sv[2][4];
#pragma unroll
        for (int ai = 0; ai < 2; ++ai)
#pragma unroll
            for (int m = 0; m < 4; ++m) sv[ai][m] = rs[row0 + ai * HALF + m * 16];
#pragma unroll
        for (int ai = 0; ai < 2; ++ai)
#pragma unroll
            for (int m = 0; m < 4; ++m) { const int row = row0 + ai * HALF + m * 16; const float s = sv[ai][m]; bf16_t* rowp = O + (size_t)row * ldc + col0;
#pragma unroll
                for (int bj = 0; bj < 2; ++bj) { const f32x4 v0 = acc[ai][bj][m][0] * s, v1 = acc[ai][bj][m][1] * s;
                    u32x4 w; w.x = cvt_pk_bf16(v0[0], v0[1]); w.y = cvt_pk_bf16(v0[2], v0[3]); w.z = cvt_pk_bf16(v1[0], v1[1]); w.w = cvt_pk_bf16(v1[2], v1[3]);
                    *(u32x4*)(rowp + bj * HALF) = w; } }
    }
};
template <int LDC> struct EpiBf16 {
    static constexpr bool PERM = true, AFTER_DRAIN = false;
    static constexpr size_t ldc = LDC;
    bf16_t* O;
    __device__ __forceinline__ void operator()(const f32x4 (&acc)[2][2][4][2], const Unit& u, int wr, int wc, int fr, int fq) const {
        const int row0 = u.pm * BM + wr * 64 + fr, col0 = u.pn * BM + wc * 32 + 8 * fq;
#pragma unroll
        for (int ai = 0; ai < 2; ++ai)
#pragma unroll
            for (int m = 0; m < 4; ++m) { bf16_t* rowp = O + (size_t)(row0 + ai * HALF + m * 16) * ldc + col0;
#pragma unroll
                for (int bj = 0; bj < 2; ++bj) { const f32x4 v0 = acc[ai][bj][m][0], v1 = acc[ai][bj][m][1];
                    u32x4 w; w.x = cvt_pk_bf16(v0[0], v0[1]); w.y = cvt_pk_bf16(v0[2], v0[3]); w.z = cvt_pk_bf16(v1[0], v1[1]); w.w = cvt_pk_bf16(v1[2], v1[3]);
                    *(u32x4*)(rowp + bj * HALF) = w; } }
    }
};
struct EpiVt {
    static constexpr bool PERM = true, AFTER_DRAIN = false;
    bf16_t* O;
    __device__ __forceinline__ void operator()(const f32x4 (&acc)[2][2][4][2], const Unit& u, int wr, int wc, int fr, int fq) const {
        const int row0 = u.pm * BM + wr * 64 + fr, col0 = u.pn * BM + wc * 32 + 8 * fq;
#pragma unroll
        for (int ai = 0; ai < 2; ++ai)
#pragma unroll
            for (int m = 0; m < 4; ++m) { const int row = row0 + ai * HALF + m * 16;
#pragma unroll
                for (int bj = 0; bj < 2; ++bj) { const int col = col0 + bj * HALF; const f32x4 v0 = acc[ai][bj][m][0], v1 = acc[ai][bj][m][1];
                    u32x4 w; w.x = cvt_pk_bf16(v0[0], v0[1]); w.y = cvt_pk_bf16(v0[2], v0[3]); w.z = cvt_pk_bf16(v1[0], v1[1]); w.w = cvt_pk_bf16(v1[2], v1[3]);
                    *(u32x4*)(O + ((size_t)(col >> 6) * 512 + row) * 64 + (col & 63)) = w; } }
    }
};
__device__ __forceinline__ float sq8(const u32x4 w) { return (bflo(w.x) * bflo(w.x) + bfhi(w.x) * bfhi(w.x)) + (bflo(w.y) * bflo(w.y) + bfhi(w.y) * bfhi(w.y)) + (bflo(w.z) * bflo(w.z) + bfhi(w.z) * bfhi(w.z)) + (bflo(w.w) * bflo(w.w) + bfhi(w.w) * bfhi(w.w)); }
struct EpiResAddB {
    static constexpr bool PERM = true, AFTER_DRAIN = false;
    bf16_t* X; float* slot;
    __device__ __forceinline__ void operator()(const f32x4 (&acc)[2][2][4][2], const Unit& u, int wr, int wc, int fr, int fq) const {
        const int row0 = u.pm * BM + wr * 64 + fr, col0 = u.pn * BM + wc * 32 + 8 * fq;
#pragma unroll
        for (int ai = 0; ai < 2; ++ai) {
            u32x4 o[4][2];
#pragma unroll
            for (int m = 0; m < 4; ++m)
#pragma unroll
                for (int bj = 0; bj < 2; ++bj) o[m][bj] = *(const u32x4*)(X + (size_t)(row0 + ai * HALF + m * 16) * D + col0 + bj * HALF);
#pragma unroll
            for (int m = 0; m < 4; ++m) { bf16_t* rowp = X + (size_t)(row0 + ai * HALF + m * 16) * D + col0;
                float ss = 0.f;
#pragma unroll
                for (int bj = 0; bj < 2; ++bj) { const f32x4 v0 = acc[ai][bj][m][0], v1 = acc[ai][bj][m][1]; const u32x4 q = o[m][bj];
                    u32x4 w; w.x = cvt_pk_bf16(bflo(q.x) + v0[0], bfhi(q.x) + v0[1]); w.y = cvt_pk_bf16(bflo(q.y) + v0[2], bfhi(q.y) + v0[3]);
                    w.z = cvt_pk_bf16(bflo(q.z) + v1[0], bfhi(q.z) + v1[1]); w.w = cvt_pk_bf16(bflo(q.w) + v1[2], bfhi(q.w) + v1[3]);
                    *(u32x4*)(rowp + bj * HALF) = w; ss += sq8(w); }
                ss += shx<16>(ss); ss += shx32(ss, fq * 16 + fr);
                if (fq == 0) slot[(size_t)(row0 + ai * HALF + m * 16) * 16 + 4 * u.pn + wc] = ss; }
        }
    }
};
struct EpiResInitB {
    static constexpr bool PERM = true, AFTER_DRAIN = false;
    bf16_t* X; const float* meta; const float* xp; const float* xs; float* slot;
    __device__ __forceinline__ void operator()(const f32x4 (&acc)[2][2][4][2], const Unit& u, int wr, int wc, int fr, int fq) const {
        const int row0 = u.pm * BM + wr * 64 + fr, col0 = u.pn * BM + wc * 32 + 8 * fq;
#pragma unroll
        for (int ai = 0; ai < 2; ++ai) {
            f32x4 o[4][2][2];
#pragma unroll
            for (int m = 0; m < 4; ++m) { int r = row0 + ai * HALF + m * 16; if (r >= M) r = 0;
                const float* src;
                if (r < MP) { const int b = r / TP, t = r - b * TP; src = (t < NMETA) ? meta + (size_t)t * D : xp + ((size_t)b * SEQ + (t - NMETA)) * D; }
                else src = xs + (size_t)(r - MP) * D;
                src += col0;
#pragma unroll
                for (int bj = 0; bj < 2; ++bj)
#pragma unroll
                    for (int n = 0; n < 2; ++n) o[m][bj][n] = *(const f32x4*)(src + bj * HALF + 4 * n); }
#pragma unroll
            for (int m = 0; m < 4; ++m) { const int r = row0 + ai * HALF + m * 16;
                float ss = 0.f;
                bf16_t* rowp = X + (size_t)r * D + col0;
#pragma unroll
                for (int bj = 0; bj < 2; ++bj) { const f32x4 v0 = acc[ai][bj][m][0] + o[m][bj][0], v1 = acc[ai][bj][m][1] + o[m][bj][1];
                    u32x4 w; w.x = cvt_pk_bf16(v0[0], v0[1]); w.y = cvt_pk_bf16(v0[2], v0[3]); w.z = cvt_pk_bf16(v1[0], v1[1]); w.w = cvt_pk_bf16(v1[2], v1[3]);
                    if (r < M) *(u32x4*)(rowp + bj * HALF) = w;
                    ss += sq8(w); }
                ss += shx<16>(ss); ss += shx32(ss, fq * 16 + fr);
                if (fq == 0 && r < M) slot[(size_t)r * 16 + 4 * u.pn + wc] = ss; }
        }
    }
};
struct EpiFinalB {
    static constexpr bool PERM = true, AFTER_DRAIN = false;
    const bf16_t* X; float* out;
    __device__ __forceinline__ void operator()(const f32x4 (&acc)[2][2][4][2], const Unit& u, int wr, int wc, int fr, int fq) const {
        const int row0 = u.pm * BM + wr * 64 + fr, col0 = u.pn * BM + wc * 32 + 8 * fq;
#pragma unroll
        for (int ai = 0; ai < 2; ++ai) {
            u32x4 o[4][2];
#pragma unroll
            for (int m = 0; m < 4; ++m)
#pragma unroll
                for (int bj = 0; bj < 2; ++bj) o[m][bj] = *(const u32x4*)(X + (size_t)(row0 + ai * HALF + m * 16) * D + col0 + bj * HALF);
#pragma unroll
            for (int m = 0; m < 4; ++m) { const int r = row0 + ai * HALF + m * 16; float* dst = nullptr;
                if (r < MP) { const int b = r / TP, t = r - b * TP; if (t >= NMETA) dst = out + O_YP + ((size_t)b * SEQ + (t - NMETA)) * D; }
                else if (r < M) dst = out + O_YS + (size_t)(r - MP) * D;
                if (dst) {
#pragma unroll
                    for (int bj = 0; bj < 2; ++bj) { const u32x4 q = o[m][bj]; const f32x4 v0 = acc[ai][bj][m][0], v1 = acc[ai][bj][m][1];
                        *(f32x4*)(dst + col0 + bj * HALF) = (f32x4){bflo(q.x) + v0[0], bfhi(q.x) + v0[1], bflo(q.y) + v0[2], bfhi(q.y) + v0[3]};
                        *(f32x4*)(dst + col0 + bj * HALF + 4) = (f32x4){bflo(q.z) + v1[0], bfhi(q.z) + v1[1], bflo(q.w) + v1[2], bfhi(q.w) + v1[3]}; } } }
        }
    }
};
struct EpiSwiglu {
    static constexpr bool PERM = true, AFTER_DRAIN = false;
    bf16_t* O; const float* rs;
    __device__ __forceinline__ void operator()(const f32x4 (&acc)[2][2][4][2], const Unit& u, int wr, int wc, int fr, int fq) const {
        const int row0 = u.pm * BM + wr * 64 + fr, col0 = u.pn * HALF + wc * 32 + 8 * fq;
        float sv[2][4];
#pragma unroll
        for (int ai = 0; ai < 2; ++ai)
#pragma unroll
            for (int m = 0; m < 4; ++m) sv[ai][m] = rs[row0 + ai * HALF + m * 16];
#pragma unroll
        for (int ai = 0; ai < 2; ++ai)
#pragma unroll
            for (int m = 0; m < 4; ++m) { const int row = row0 + ai * HALF + m * 16; const float s = sv[ai][m]; bf16_t* rowp = O + (size_t)row * DFF + col0;
                float r[8];
#pragma unroll
                for (int n = 0; n < 2; ++n)
#pragma unroll
                    for (int j = 0; j < 4; ++j) { const float g = acc[ai][0][m][n][j] * s, up = acc[ai][1][m][n][j] * s;
                        r[n * 4 + j] = g * up * __builtin_amdgcn_rcpf(1.0f + __builtin_amdgcn_exp2f(-1.4426950408889634f * g)); }
                u32x4 w; w.x = cvt_pk_bf16(r[0], r[1]); w.y = cvt_pk_bf16(r[2], r[3]); w.z = cvt_pk_bf16(r[4], r[5]); w.w = cvt_pk_bf16(r[6], r[7]);
                *(u32x4*)rowp = w; }
    }
};

template <class Epi, class Sched, bool ALIGN_EPI = false, bool SP2 = false>
__device__ __forceinline__ void gemm_phase(LAS unsigned char* lds, const Gemm g, const Sched& S, const Epi& E) {
    int tid = threadIdx.x; asm volatile("" : "+v"(tid));
    const int wid = __builtin_amdgcn_readfirstlane(tid >> 6), lane = tid & 63, wr = wid >> 2, wc = wid & 3, fr = lane & 15, fq = lane >> 4;
    const int K = g.K, nt = K / BK;
    unsigned voffA[2], voffB[2];
#pragma unroll
    for (int i = 0; i < 2; ++i) { int R, C; stage_rc(tid * 16 + i * 8192, R, C); const int Rb = Epi::PERM ? ((R & ~31) + perm32(R & 31)) : R;
        voffA[i] = (unsigned)(R * K + C) * 2u; voffB[i] = (unsigned)(Rb * K + C) * 2u; }
    const size_t kstep = (size_t)(BK * 2);
    const size_t hstep = (size_t)HALF * K * 2;
    const size_t tstep = 2 * hstep;
    const unsigned ldsw = (unsigned)wid * 1024u;
    const int aoff = lds_byte(wr * 64 + fr, fq * 8), boff = lds_byte(wc * 32 + fr, fq * 8);
#define PG8_SA(b, h) (((b) * 2 + (h)) * HTB)
#define PG8_SB(b, h) ((4 + (b) * 2 + (h)) * HTB)
#define PG8_STAGE(bufoff, gbase, voff) do { _Pragma("unroll") for (int _i = 0; _i < 2; ++_i) \
        __builtin_amdgcn_global_load_lds((const unsigned*)((const char*)(gbase) + (voff)[_i]), (LAS unsigned*)(lds + (bufoff) + ldsw + _i * 8192), 16, 0, 0); } while (0)
#define PG8_LDA(dst, b, h) do { _Pragma("unroll") for (int m = 0; m < 4; ++m) _Pragma("unroll") for (int k = 0; k < 2; ++k) dst[m][k] = *(const LAS bf16x8*)(lds + PG8_SA(b, h) + aoff + m * 2048 + k * 1024); } while (0)
#define PG8_LDB(dst, b, h) do { _Pragma("unroll") for (int n = 0; n < 2; ++n) _Pragma("unroll") for (int k = 0; k < 2; ++k) dst[n][k] = *(const LAS bf16x8*)(lds + PG8_SB(b, h) + boff + n * 2048 + k * 1024); } while (0)
#define PG8_MMA(ai, bj, At, Bt) do { __builtin_amdgcn_s_setprio(1); _Pragma("unroll") for (int m = 0; m < 4; ++m) _Pragma("unroll") for (int n = 0; n < 2; ++n) _Pragma("unroll") for (int k = 0; k < 2; ++k) \
        acc[ai][bj][m][n] = __builtin_amdgcn_mfma_f32_16x16x32_bf16(Bt[n][k], At[m][k], acc[ai][bj][m][n], 0, 0, 0); __builtin_amdgcn_s_setprio(0); } while (0)
#define PG8_WAIT_V(n) asm volatile("s_waitcnt vmcnt(" #n ")" ::: "memory")
#define PG8_WAIT_L(n) asm volatile("s_waitcnt lgkmcnt(" #n ")" ::: "memory")
#define PG8_BAR __builtin_amdgcn_s_barrier()
#define PG8_SCHED __builtin_amdgcn_sched_barrier(0)
    Unit cur, nxt; int ui = 0;
    if (!S.next(0, cur)) return;
    f32x4 acc[2][2][4][2];
#pragma unroll
    for (int a = 0; a < 2; ++a)
#pragma unroll
        for (int b = 0; b < 2; ++b)
#pragma unroll
            for (int m = 0; m < 4; ++m)
#pragma unroll
                for (int n = 0; n < 2; ++n) acc[a][b][m][n] = (f32x4){0.f, 0.f, 0.f, 0.f};
    bf16x8 At[4][2], B0[2][2], B1[2][2];
    const char* cA = (const char*)g.A + (size_t)cur.pm * tstep; const char* cB = (const char*)g.Bt + (size_t)cur.pn * tstep;
    S.a_ready(cur);
    if constexpr (SP2) {
        PG8_STAGE(PG8_SB(0, 0), cB, voffB); PG8_STAGE(PG8_SB(0, 1), cB + hstep, voffB); PG8_STAGE(PG8_SA(0, 0), cA, voffA); PG8_STAGE(PG8_SA(0, 1), cA + hstep, voffA);
        if (wr == 1) PG8_BAR;
        PG8_WAIT_V(2); PG8_BAR;
        PG8_STAGE(PG8_SB(1, 0), cB + kstep, voffB); PG8_STAGE(PG8_SA(1, 0), cA + kstep, voffA); PG8_STAGE(PG8_SB(1, 1), cB + hstep + kstep, voffB);
        PG8_WAIT_V(6); PG8_BAR;
    } else {
        PG8_STAGE(PG8_SB(0, 0), cB, voffB); PG8_STAGE(PG8_SA(0, 0), cA, voffA); PG8_STAGE(PG8_SB(0, 1), cB + hstep, voffB); PG8_STAGE(PG8_SA(0, 1), cA + hstep, voffA);
        if (wr == 1) PG8_BAR;
        PG8_WAIT_V(4); PG8_BAR;
        PG8_STAGE(PG8_SB(1, 0), cB + kstep, voffB); PG8_STAGE(PG8_SA(1, 0), cA + kstep, voffA); PG8_STAGE(PG8_SB(1, 1), cB + hstep + kstep, voffB);
        PG8_WAIT_V(6); PG8_BAR;
    }
    for (;;) {
        const bool has_next = S.next(ui + 1, nxt);
        const char* nA = has_next ? (const char*)g.A + (size_t)nxt.pm * tstep : cA; const char* nB = has_next ? (const char*)g.Bt + (size_t)nxt.pn * tstep : cB;
#pragma nounroll
        for (int t = 0; t < nt; t += 2) {
            const bool last = (t == nt - 2);
            const char* a1 = cA + (size_t)(t + 1) * kstep;
            const char* a2 = last ? nA : cA + (size_t)(t + 2) * kstep; const char* b2 = last ? nB : cB + (size_t)(t + 2) * kstep;
            const char* a3 = a2 + kstep; const char* b3 = b2 + kstep;
            if (last && has_next) S.a_ready(nxt);
            if constexpr (SP2) {
            PG8_LDB(B0, 0, 0); PG8_LDB(B1, 0, 1); PG8_SCHED; PG8_LDA(At, 0, 0); PG8_STAGE(PG8_SA(1, 1), a1 + hstep, voffA);
            PG8_WAIT_V(8); PG8_WAIT_L(0); PG8_BAR; PG8_MMA(0, 0, At, B0); PG8_MMA(0, 1, At, B1); PG8_BAR; PG8_SCHED;
            PG8_LDA(At, 0, 1); PG8_STAGE(PG8_SB(0, 0), b2, voffB); PG8_STAGE(PG8_SB(0, 1), b2 + hstep, voffB); PG8_STAGE(PG8_SA(0, 0), a2, voffA);
            PG8_WAIT_V(8); PG8_WAIT_L(0); PG8_BAR; PG8_MMA(1, 0, At, B0); PG8_MMA(1, 1, At, B1); PG8_BAR; PG8_SCHED;
            PG8_LDB(B0, 1, 0); PG8_LDB(B1, 1, 1); PG8_SCHED; PG8_LDA(At, 1, 0); PG8_STAGE(PG8_SA(0, 1), a2 + hstep, voffA);
            PG8_WAIT_V(8); PG8_WAIT_L(0); PG8_BAR; PG8_MMA(0, 0, At, B0); PG8_MMA(0, 1, At, B1); PG8_BAR; PG8_SCHED;
            PG8_LDA(At, 1, 1); PG8_STAGE(PG8_SB(1, 0), b3, voffB); PG8_STAGE(PG8_SB(1, 1), b3 + hstep, voffB); PG8_STAGE(PG8_SA(1, 0), a3, voffA);
            PG8_WAIT_V(8); PG8_WAIT_L(0); PG8_BAR; PG8_MMA(1, 0, At, B0); PG8_MMA(1, 1, At, B1); PG8_BAR; PG8_SCHED;
            } else {
            PG8_LDB(B0, 0, 0); PG8_SCHED; PG8_LDA(At, 0, 0); PG8_STAGE(PG8_SA(1, 1), a1 + hstep, voffA);
            PG8_WAIT_L(8); PG8_BAR; PG8_WAIT_L(0); PG8_MMA(0, 0, At, B0); PG8_BAR; PG8_SCHED;
            PG8_LDB(B1, 0, 1); PG8_STAGE(PG8_SB(0, 0), b2, voffB);
            PG8_BAR; PG8_WAIT_L(0); PG8_MMA(0, 1, At, B1); PG8_BAR;
            PG8_LDA(At, 0, 1); PG8_STAGE(PG8_SA(0, 0), a2, voffA);
            PG8_BAR; PG8_WAIT_L(0); PG8_MMA(1, 0, At, B0); PG8_BAR; PG8_SCHED;
            PG8_STAGE(PG8_SB(0, 1), b2 + hstep, voffB);
            PG8_WAIT_V(6); PG8_BAR; PG8_MMA(1, 1, At, B1); PG8_BAR;
            PG8_LDB(B0, 1, 0); PG8_SCHED; PG8_LDA(At, 1, 0); PG8_STAGE(PG8_SA(0, 1), a2 + hstep, voffA);
            PG8_WAIT_L(8); PG8_BAR; PG8_WAIT_L(0); PG8_MMA(0, 0, At, B0); PG8_BAR; PG8_SCHED;
            PG8_LDB(B1, 1, 1); PG8_STAGE(PG8_SB(1, 0), b3, voffB);
            PG8_BAR; PG8_WAIT_L(0); PG8_MMA(0, 1, At, B1); PG8_BAR;
            PG8_LDA(At, 1, 1); PG8_STAGE(PG8_SA(1, 0), a3, voffA);
            PG8_BAR; PG8_WAIT_L(0); PG8_MMA(1, 0, At, B0); PG8_BAR; PG8_SCHED;
            PG8_STAGE(PG8_SB(1, 1), b3 + hstep, voffB);
            PG8_WAIT_V(6); PG8_BAR; PG8_MMA(1, 1, At, B1); PG8_BAR;
            }
        }
        if constexpr (ALIGN_EPI) { if (wr == 0) PG8_BAR; }
        E(acc, cur, wr, wc, fr, fq); S.done(cur);
        if (!has_next) break;
#pragma unroll
        for (int a = 0; a < 2; ++a)
#pragma unroll
            for (int b = 0; b < 2; ++b)
#pragma unroll
                for (int m = 0; m < 4; ++m)
#pragma unroll
                    for (int n = 0; n < 2; ++n) acc[a][b][m][n] = (f32x4){0.f, 0.f, 0.f, 0.f};
        cur = nxt; cA = nA; cB = nB; ++ui;
        if constexpr (ALIGN_EPI) { if (wr == 1) PG8_BAR; }
    }
    PG8_WAIT_V(0);
    if constexpr (!ALIGN_EPI) { if (wr == 0) PG8_BAR; }
    PG8_BAR;
#undef PG8_SA
#undef PG8_SB
#undef PG8_STAGE
#undef PG8_LDA
#undef PG8_LDB
#undef PG8_MMA
#undef PG8_WAIT_V
#undef PG8_WAIT_L
#undef PG8_BAR
#undef PG8_SCHED
}
}

template <class Epi>
__device__ __forceinline__ void run_gemm(LAS unsigned char* lds, const bf16_t* A, const bf16_t* Bt, int Mm, int Nn, int Kk, const Epi& E, int rot) {
    pg8::Gemm g{A, Bt, Mm, Nn, Kk};
    pg8::StaticOrder S; S.init(Mm, Nn, (int)gridDim.x, (int)((blockIdx.x + rot) % gridDim.x));
    pg8::gemm_phase<Epi, pg8::StaticOrder, true, true>(lds, g, S, E);
}

__device__ __forceinline__ int opaque_tid() { int t = threadIdx.x; asm volatile("" : "+v"(t)); return t; }
struct XJob { const float* W; const float* W2; int ldw; int k0; int Ksz; int Nd; int nvalid; int mode; bf16_t* dst; int ldd; int kc0; const float* kscale; };
__device__ __forceinline__ void xpose_load(const XJob& J, int tile, int tid, float (&v)[8]) {
    const int ktiles = J.Ksz / 64, nt = tile / ktiles, kt = tile % ktiles, n0 = nt * 64, kk0 = kt * 64;
    const float* src = J.W; int scol0 = n0;
    if (J.mode == 1) { const int pn = n0 / 256, rem = n0 % 256; src = (rem >= 128) ? J.W2 : J.W; scol0 = 128 * pn + (rem & 127); }
    const int nl = tid & 63, kq = tid >> 6;
    const bool ok = (n0 + nl) < J.nvalid;
    int scol = scol0 + nl;
    if (J.mode == 2) { const int n = n0 + nl, pn = n >> 8, cp = n & 255, bj = cp >> 7, wc = (cp & 127) >> 5, jj = cp & 31; scol = (4 * pn + wc) * 64 + 32 * bj + jj; }
    if (!ok) scol = scol0;
#pragma unroll
    for (int i = 0; i < 8; ++i) { const int kl = kq + 8 * i; const float ksc = J.kscale ? J.kscale[J.k0 + kk0 + kl] : 1.f; const float w = src[(size_t)(J.k0 + kk0 + kl) * J.ldw + scol]; v[i] = ok ? w * ksc : 0.f; }
}
__device__ __forceinline__ void xpose_store(const XJob& J, int tile, int tid, const float (&v)[8], LAS float* scr, int next_tile, float (&vn)[8]) {
    const int ktiles = J.Ksz / 64, nt = tile / ktiles, kt = tile % ktiles, n0 = nt * 64, kk0 = kt * 64;
    { const int nl = tid & 63, kq = tid >> 6;
#pragma unroll
      for (int i = 0; i < 8; ++i) scr[(kq + 8 * i) * 65 + nl] = v[i]; }
    __syncthreads();
    if (next_tile >= 0) xpose_load(J, next_tile, tid, vn);
    {
        const int k8 = tid & 7, nl = tid >> 3;
        const LAS float* s = scr + (8 * k8) * 65 + nl;
        u32x4 o; o.x = pk2(s[0], s[65]); o.y = pk2(s[2 * 65], s[3 * 65]); o.z = pk2(s[4 * 65], s[5 * 65]); o.w = pk2(s[6 * 65], s[7 * 65]);
        *(u32x4*)(J.dst + (size_t)(n0 + nl) * J.ldd + J.kc0 + kk0 + 8 * k8) = o;
    }
    __syncthreads();
}
__device__ __forceinline__ void phase_prep(const Params& p, LAS unsigned char* lds, int l, int jmask, int vb, int vg) {
    LAS float* scr = (LAS float*)lds;
    bf16_t* wts = (bf16_t*)(p.ws + WS_WTS);
    {
        bf16_t* wl = wts + (size_t)l * W_LAYER;
        for (int j = 0; j < 7; ++j) {
            if (!((jmask >> j) & 1)) continue;
            XJob J;
            switch (j) {
                case 0: J = XJob{p.w_in + (size_t)l * D * DIN, nullptr, DIN, 0, D, DINP, DIN, 0, wl + W_IN, D, 0, p.norm_mix + (size_t)l * D}; break;
                case 1: J = XJob{p.w_uq + (size_t)l * QRK * 768, nullptr, 768, 0, QRK, 768, 768, 0, wl + W_UQ, QRK, 0, nullptr}; break;
                case 2: J = XJob{p.w_uk + (size_t)l * KVR * 512, nullptr, 512, 0, KVR, 512, 512, 2, wl + W_UK, KVR, 0, nullptr}; break;
                case 3: J = XJob{p.w_uv + (size_t)l * KVR * 512, nullptr, 512, 0, KVR, 512, 512, 0, wl + W_UV, KVR, 0, nullptr}; break;
                case 4: J = XJob{p.w_o + (size_t)l * D * D, nullptr, D, 512, 512, D, D, 0, wl + W_O, D, 512, nullptr}; break;
                case 5: J = XJob{p.w_gate + (size_t)l * D * DFF, p.w_up + (size_t)l * D * DFF, DFF, 0, D, 2 * DFF, 2 * DFF, 1, wl + W_GU, D, 0, p.norm_ffn + (size_t)l * D}; break;
                default: J = XJob{p.w_down + (size_t)l * DFF * D, nullptr, D, 0, DFF, D, D, 0, wl + W_DN, DFF, 0, nullptr}; break;
            }
            const int ntiles = (J.Nd / 64) * (J.Ksz / 64);
            {
                const int tid = opaque_tid(), G = vg;
                float v[8], vn[8];
                int t = vb;
                if (t < ntiles) xpose_load(J, t, tid, v);
                for (; t < ntiles; t += G) {
                    const int tn = (t + G < ntiles) ? t + G : -1;
                    xpose_store(J, t, tid, v, scr, tn, vn);
#pragma unroll
                    for (int i = 0; i < 8; ++i) v[i] = vn[i];
                }
            }
        }
        const float* wp = p.w_pool + (size_t)l * 4 * 128 * 128; const float* ps = p.pool_scale + (size_t)l * PW; const float* wo = p.w_o + (size_t)l * D * D;
        if ((jmask >> 7) & 1)
        for (int idx = vb * 512 + opaque_tid(); idx < 64 * 1024; idx += vg * 512) {
            const int k8 = idx >> 10, n = idx & 1023, k0 = k8 * 8, g = k0 >> 7, kk0 = k0 & 127;
            const float* wpr = wp + ((size_t)g * 128 + kk0) * 128;
            float s[8] = {0.f, 0.f, 0.f, 0.f, 0.f, 0.f, 0.f, 0.f};
#pragma nounroll
            for (int j0 = 0; j0 < 128; j0 += 16) {
                float t[16];
#pragma unroll
                for (int jj = 0; jj < 16; ++jj) t[jj] = ps[g * 128 + j0 + jj] * wo[(size_t)(g * 128 + j0 + jj) * D + n];
#pragma unroll
                for (int e = 0; e < 8; ++e) { const f32x4* wq = (const f32x4*)(wpr + e * 128 + j0); const f32x4 a = wq[0], b = wq[1], c = wq[2], d = wq[3];
                    s[e] += ((a.x * t[0] + a.y * t[1]) + (a.z * t[2] + a.w * t[3])) + ((b.x * t[4] + b.y * t[5]) + (b.z * t[6] + b.w * t[7]))
                          + ((c.x * t[8] + c.y * t[9]) + (c.z * t[10] + c.w * t[11])) + ((d.x * t[12] + d.y * t[13]) + (d.z * t[14] + d.w * t[15])); }
            }
            u32x4 w; w.x = pk2(s[0], s[1]); w.y = pk2(s[2], s[3]); w.z = pk2(s[4], s[5]); w.w = pk2(s[6], s[7]);
            *(u32x4*)(wl + W_O + (size_t)n * D + k0) = w;
        }
    }
}

__device__ __forceinline__ void phase_rmsnorm_first(const Params& p) {
    const int tid_ = opaque_tid(), lane = tid_ & 63, gw = blockIdx.x * 8 + (tid_ >> 6), NW = gridDim.x * 8;
    bf16_t* xrb = (bf16_t*)(p.ws + WS_XRES); float* rs = (float*)(p.ws + WS_RS);
    constexpr int U = 4;
    for (int r0 = gw; r0 < M; r0 += NW * U) {
        f32x4 v[U][4]; float ss[U];
#pragma unroll
        for (int u = 0; u < U; ++u) {
            int r = r0 + u * NW; if (r >= M) r = r0;
            const float* src;
            if (r < MP) { const int b = r / TP, t = r - b * TP; src = (t < NMETA) ? p.meta + (size_t)t * D : p.x_prompt + ((size_t)b * SEQ + (t - NMETA)) * D; }
            else src = p.x_sample + (size_t)(r - MP) * D;
#pragma unroll
            for (int j = 0; j < 4; ++j) v[u][j] = *(const f32x4*)(src + 4 * lane + 256 * j);
        }
        u32x2 w[U][4];
#pragma unroll
        for (int u = 0; u < U; ++u) { float s = 0.f;
#pragma unroll
            for (int j = 0; j < 4; ++j) { w[u][j].x = pk2(v[u][j].x, v[u][j].y); w[u][j].y = pk2(v[u][j].z, v[u][j].w);
                s += (bflo(w[u][j].x) * bflo(w[u][j].x) + bfhi(w[u][j].x) * bfhi(w[u][j].x)) + (bflo(w[u][j].y) * bflo(w[u][j].y) + bfhi(w[u][j].y) * bfhi(w[u][j].y)); }
            ss[u] = s; }
#pragma unroll
        for (int u = 0; u < U; ++u) ss[u] = wave_sum(ss[u], lane);
#pragma unroll
        for (int u = 0; u < U; ++u) {
            const int r = r0 + u * NW;
            if (r < M) {
#pragma unroll
                for (int j = 0; j < 4; ++j) *(u32x2*)(xrb + (size_t)r * D + 4 * lane + 256 * j) = w[u][j];
                if (lane == 0) rs[r] = rsqrtf(ss[u] * (1.f / D) + EPS);
            }
        }
    }
    for (int r = M + blockIdx.x * 512 + opaque_tid(); r < MPAD; r += gridDim.x * 512) rs[r] = 0.f;
}
__device__ __forceinline__ void phase_rowstat(const Params& p) {
    const float* slot = (const float*)(p.ws + WS_SLOT); float* rs = (float*)(p.ws + WS_RS);
    for (int r = blockIdx.x * 512 + opaque_tid(); r < MPAD; r += gridDim.x * 512) {
        float o = 0.f;
        if (r < M) { const f32x4* sp = (const f32x4*)(slot + (size_t)r * 16); const f32x4 a = sp[0], b = sp[1], c = sp[2], d = sp[3];
            const float s = ((a.x + a.y) + (a.z + a.w)) + ((b.x + b.y) + (b.z + b.w)) + ((c.x + c.y) + (c.z + c.w)) + ((d.x + d.y) + (d.z + d.w));
            o = rsqrtf(s * (1.f / D) + EPS); }
        rs[r] = o;
    }
}

__device__ __forceinline__ void phase_cacheconv(const Params& p, int l, int vb, int vg) {
    bf16_t* lat = (bf16_t*)(p.ws + WS_HBUF);

        const f32x4* cl = (const f32x4*)(p.cache_latent + (size_t)l * DB * CROWS * KVR);
        constexpr int n4 = DB * CROWS * (KVR / 4);
        const int T = vg * 512;
        for (int i0 = vb * 512 + opaque_tid(); i0 < n4; i0 += T * 8) {
            f32x4 v[8];
#pragma unroll
            for (int u = 0; u < 8; ++u) { int i = i0 + u * T; if (i >= n4) i = i0; v[u] = cl[i]; }
#pragma unroll
            for (int u = 0; u < 8; ++u) { const int i = i0 + u * T;
                if (i < n4) { const int row = i >> 6, b = row / CROWS, j = row - b * CROWS;
                    u32x2 w; w.x = pk2(v[u].x, v[u].y); w.y = pk2(v[u].z, v[u].w);
                    *(u32x2*)(lat + ((size_t)MP + (size_t)b * SKP + j) * KVR + (i & 63) * 4) = w; } }
        }
        {
            float* ssk = (float*)(p.ws + WS_SSK);
            const float* ck = p.cache_krope + (size_t)l * DB * CROWS * DROPE;
            for (int i = vb * 512 + opaque_tid(); i < DB * SKP; i += vg * 512) {
                const int b = i / SKP, j = i - b * SKP;
                if (j < CROWS) { const f32x4* rp = (const f32x4*)(ck + ((size_t)b * CROWS + j) * DROPE); float s = 0.f;
#pragma unroll
                    for (int e = 0; e < 8; ++e) { const f32x4 v = rp[e]; s += (v.x * v.x + v.y * v.y) + (v.z * v.z + v.w * v.w); }
                    ssk[MP + i] = s; }
                else if (j >= SK) ssk[MP + i] = 0.f;
            }
        }
        const int npad = DB * (SKP - SK) * KVR / 4;
        for (int i = vb * 512 + opaque_tid(); i < npad; i += vg * 512) {
            const int e = i * 4, b = e / ((SKP - SK) * KVR), rem = e % ((SKP - SK) * KVR);
            u32x2 w; w.x = 0u; w.y = 0u;
            *(u32x2*)(lat + ((size_t)MP + (size_t)b * SKP + SK) * KVR + rem) = w;
        }
    }
__device__ __forceinline__ void phase_postin(const Params& p, int l) {
    const int tid_ = opaque_tid(), lane = tid_ & 63, gw = blockIdx.x * 8 + (tid_ >> 6), NW = gridDim.x * 8;
    const bf16_t* z = (const bf16_t*)(p.ws + WS_ACT);
    bf16_t* lat = (bf16_t*)(p.ws + WS_HBUF);
    bf16_t* mix = (bf16_t*)(p.ws + WS_MIX);
    bf16_t* qa = (bf16_t*)((unsigned char*)p.out + (size_t)KRPAD * 512 * 2);
    const float* qg = p.q_a_norm + (size_t)l * QRK; const float* kg = p.kv_a_norm + (size_t)l * KVR;
    f32x2 qgv[3];
#pragma unroll
    for (int j = 0; j < 3; ++j) qgv[j] = *(const f32x2*)(qg + 2 * lane + 128 * j);
    const f32x4 kgv = *(const f32x4*)(kg + 4 * lane);
    const double invf = INVF[lane & 15];
    constexpr int U = 3;
    for (int r0 = gw; r0 < M; r0 += NW * U) {
        f32x2 qv[U][3]; f32x4 kvv[U], uA[U], uB[U], sA[U], sB[U]; float x1[U], x2[U];
#pragma unroll
        for (int u = 0; u < U; ++u) {
            int r = r0 + u * NW; if (r >= M) r = r0;
            const bf16_t* zr = z + (size_t)r * DINP;
            const bool prompt = r < MP;
            int b, t;
            if (prompt) { b = r / TP; t = r - b * TP; } else { b = (r - MP) / DS; t = (r - MP) - b * DS; }
#pragma unroll
            for (int j = 0; j < 3; ++j) qv[u][j] = ld2(zr + PW + 2 * lane + 128 * j);
            kvv[u] = ld4(zr + PW + QRK + 4 * lane);
            x1[u] = bflo((unsigned)zr[PW + QRK + KVR + (lane & 15)]); x2[u] = bflo((unsigned)zr[PW + QRK + KVR + 16 + (lane & 15)]);
            uA[u] = ld4(zr + 4 * lane); uB[u] = ld4(zr + 256 + 4 * lane);
            const int g0 = lane >> 5;
            const int wA = 2 << g0, wB = 8 << g0;
            const int text = prompt ? t : 15 + t;
            const int cA = (text + 1 < wA) ? text + 1 : wA, cB = (text + 1 < wB) ? text + 1 : wB;
            f32x4 a = uA[u], bb = uB[u];
            if (prompt) {
                u32x2 wa[3], wb[15];
#pragma unroll
                for (int j = 1; j < 16; ++j) { const int jj = (j < t) ? j : t; const bf16_t* src = zr - (size_t)jj * DINP;
                    wb[j - 1] = *(const u32x2*)(src + 256 + 4 * lane); if (j < 4) wa[j - 1] = *(const u32x2*)(src + 4 * lane); }
#pragma unroll
                for (int j = 1; j < 16; ++j) {
                    const float mb = (j < cB) ? 1.f : 0.f;
                    bb = bb + (f32x4){bflo(wb[j - 1].x), bfhi(wb[j - 1].x), bflo(wb[j - 1].y), bfhi(wb[j - 1].y)} * mb;
                    if (j < 4) { const float ma = (j < cA) ? 1.f : 0.f; a = a + (f32x4){bflo(wa[j - 1].x), bfhi(wa[j - 1].x), bflo(wa[j - 1].y), bfhi(wa[j - 1].y)} * ma; }
                }
            } else {
                const float* hist = p.state_pool + ((size_t)l * DB + b) * 15 * PW;
                u32x2 za[3], zb[15]; f32x4 ha[3], hb[15];
#pragma unroll
                for (int j = 1; j < 16; ++j) { const int tz = (t >= j) ? t - j : 0, th = (t >= j) ? 0 : 15 + t - j;
                    const bf16_t* zs = z + ((size_t)MP + (size_t)b * DS + tz) * DINP; const float* hs = hist + (size_t)th * PW;
                    zb[j - 1] = *(const u32x2*)(zs + 256 + 4 * lane); hb[j - 1] = *(const f32x4*)(hs + 256 + 4 * lane);
                    if (j < 4) { za[j - 1] = *(const u32x2*)(zs + 4 * lane); ha[j - 1] = *(const f32x4*)(hs + 4 * lane); } }
#pragma unroll
                for (int j = 1; j < 16; ++j) {
                    const bool newrow = t >= j; const float mb = (j < cB) ? 1.f : 0.f;
                    const f32x4 zv = {bflo(zb[j - 1].x), bfhi(zb[j - 1].x), bflo(zb[j - 1].y), bfhi(zb[j - 1].y)};
                    bb = bb + (newrow ? zv : hb[j - 1]) * mb;
                    if (j < 4) { const float ma = (j < cA) ? 1.f : 0.f; const f32x4 zw = {bflo(za[j - 1].x), bfhi(za[j - 1].x), bflo(za[j - 1].y), bfhi(za[j - 1].y)};
                        a = a + (newrow ? zw : ha[j - 1]) * ma; }
                }
            }
            sA[u] = a * (1.f / (float)cA) - uA[u]; sB[u] = bb * (1.f / (float)cB) - uB[u];
        }
        float ssq[U], ssk[U];
#pragma unroll
        for (int u = 0; u < U; ++u) { ssq[u] = 0.f;
#pragma unroll
            for (int j = 0; j < 3; ++j) ssq[u] += qv[u][j].x * qv[u][j].x + qv[u][j].y * qv[u][j].y;
            ssk[u] = (kvv[u].x * kvv[u].x + kvv[u].y * kvv[u].y) + (kvv[u].z * kvv[u].z + kvv[u].w * kvv[u].w); }
#pragma unroll
        for (int u = 0; u < U; ++u) { ssq[u] = wave_sum(ssq[u], lane); ssk[u] = wave_sum(ssk[u], lane); }
#pragma unroll
        for (int u = 0; u < U; ++u) {
            const int r = r0 + u * NW;
            if (r < M) {
                const bool prompt = r < MP;
                int b, t;
                if (prompt) { b = r / TP; t = r - b * TP; } else { b = (r - MP) / DS; t = (r - MP) - b * DS; }
                const int pos = prompt ? t : CROWS + t;
                {
                    const float rs = rsqrtf(ssq[u] * (1.f / QRK) + EPS);
#pragma unroll
                    for (int j = 0; j < 3; ++j) { const f32x2 g = qgv[j]; *(unsigned*)(qa + (size_t)r * QRK + 2 * lane + 128 * j) = pk2(qv[u][j].x * rs * g.x, qv[u][j].y * rs * g.y); }
                }
                {
                    const float rs = rsqrtf(ssk[u] * (1.f / KVR) + EPS);
                    const f32x4 o = kvv[u] * rs * kgv;
                    float* dst = prompt ? p.out + O_LATP + ((size_t)l * MP + r) * KVR : p.out + O_LATS + ((size_t)l * MS + (r - MP)) * KVR;
                    *(f32x4*)(dst + 4 * lane) = o;
                    const size_t krow = prompt ? (size_t)r : (size_t)MP + (size_t)b * SKP + CROWS + t;
                    u32x2 w; w.x = pk2(o.x, o.y); w.y = pk2(o.z, o.w);
                    *(u32x2*)(lat + krow * KVR + 4 * lane) = w;
                }
                {
                    float sq = x1[u] * x1[u] + x2[u] * x2[u];
                    sq += shx<1>(sq); sq += shx<2>(sq); sq += shx<4>(sq); sq += shx<8>(sq);
                    if (lane < 16) {
                        float c, s; { const double rev = (double)pos * invf * 0.15915494309189535; const float fr = (float)(rev - floor(rev)); c = __builtin_amdgcn_cosf(fr); s = __builtin_amdgcn_sinf(fr); }
                        float* dst = prompt ? p.out + O_KPEP + ((size_t)l * MP + r) * DROPE : p.out + O_KPES + ((size_t)l * MS + (r - MP)) * DROPE;
                        dst[lane] = x1[u] * c - x2[u] * s; dst[16 + lane] = x1[u] * s + x2[u] * c;
                        if (lane == 0) { const size_t krow = prompt ? (size_t)r : (size_t)MP + (size_t)b * SKP + CROWS + t; ((float*)(p.ws + WS_SSK))[krow] = sq; }
                    }
                }
                {
                    u32x2 w; w.x = pk2(sA[u].x, sA[u].y); w.y = pk2(sA[u].z, sA[u].w); *(u32x2*)(mix + (size_t)r * D + 4 * lane) = w;
                    w.x = pk2(sB[u].x, sB[u].y); w.y = pk2(sB[u].z, sB[u].w); *(u32x2*)(mix + (size_t)r * D + 256 + 4 * lane) = w;
                    const int tail = prompt ? t - (TP - 15) : t - (DS - 15);
                    if (tail >= 0) {
                        float* dst = prompt ? p.out + O_POOLP + (((size_t)l * NB + b) * 15 + tail) * PW : p.out + O_POOLS + (((size_t)l * DB + b) * 15 + tail) * PW;
                        *(f32x4*)(dst + 4 * lane) = uA[u]; *(f32x4*)(dst + 256 + 4 * lane) = uB[u];
                    }
                }
            }
        }
    }
}

__device__ __forceinline__ const float* kpe_row(const Params& p, int l, int kr) {
    if (kr < MP) return p.out + O_KPEP + ((size_t)l * MP + kr) * DROPE;
    const int b = (kr - MP) / SKP, j = (kr - MP) - b * SKP;
    if (j < CROWS) return p.cache_krope + (((size_t)l * DB + b) * CROWS + j) * DROPE;
    if (j < SK) return p.out + O_KPES + ((size_t)l * MS + b * DS + (j - CROWS)) * DROPE;
    return nullptr;
}
struct EpiKnorm {
    static constexpr bool PERM = true, AFTER_DRAIN = false;
    Params p; int l;
    __device__ __forceinline__ void operator()(const f32x4 (&acc)[2][2][4][2], const pg8::Unit& u, int wr, int wc, int fr, int fq) const {
        bf16_t* Kn = (bf16_t*)(p.ws + WS_ACT); bf16_t* Kr = Kn + (size_t)KRPAD * 512;
        const float* ssk = (const float*)(p.ws + WS_SSK);
        const float* kn = p.k_norm + (size_t)l * DQK;
        const int h = 4 * u.pn + wc, lane = fq * 16 + fr;
        const int row0 = u.pm * 256 + wr * 64 + fr;
        f32x4 gn[2][2], gr[2];
#pragma unroll
        for (int bj = 0; bj < 2; ++bj) { gn[bj][0] = *(const f32x4*)(kn + 32 * bj + 8 * fq); gn[bj][1] = *(const f32x4*)(kn + 32 * bj + 8 * fq + 4); }
        gr[0] = *(const f32x4*)(kn + 64 + 8 * fq); gr[1] = *(const f32x4*)(kn + 64 + 8 * fq + 4);
#pragma unroll
        for (int ai = 0; ai < 2; ++ai) {
            float sk[4]; f32x4 pa[4], pc[4];
#pragma unroll
            for (int m = 0; m < 4; ++m) { const int row = row0 + ai * 128 + m * 16, rc = (row < KR) ? row : 0;
                sk[m] = ssk[rc];
                const float* kpe = kpe_row(p, l, rc); const bool has = kpe != nullptr; const float* kq = has ? kpe : kn;
                pa[m] = *(const f32x4*)(kq + 8 * fq); pc[m] = *(const f32x4*)(kq + 8 * fq + 4);
                const float mk = has ? 1.f : 0.f; pa[m] = pa[m] * mk; pc[m] = pc[m] * mk; }
#pragma unroll
            for (int m = 0; m < 4; ++m) {
                const int row = row0 + ai * 128 + m * 16;
                float ss = 0.f;
#pragma unroll
                for (int bj = 0; bj < 2; ++bj)
#pragma unroll
                    for (int n = 0; n < 2; ++n) { const f32x4 v = acc[ai][bj][m][n]; ss += (v[0] * v[0] + v[1] * v[1]) + (v[2] * v[2] + v[3] * v[3]); }
                ss += shx<16>(ss); ss += shx32(ss, lane);
                if (row < KR) {
                    const float rs = rsqrtf((ss + sk[m]) * (1.f / DQK) + EPS);
#pragma unroll
                    for (int bj = 0; bj < 2; ++bj) {
                        const f32x4 v0 = acc[ai][bj][m][0] * rs * gn[bj][0], v1 = acc[ai][bj][m][1] * rs * gn[bj][1];
                        u32x4 w; w.x = pk2(v0[0], v0[1]); w.y = pk2(v0[2], v0[3]); w.z = pk2(v1[0], v1[1]); w.w = pk2(v1[2], v1[3]);
                        *(u32x4*)(Kn + (size_t)row * 512 + h * 64 + 32 * bj + 8 * fq) = w;
                    }
                    const f32x4 a = pa[m] * rs * gr[0], c = pc[m] * rs * gr[1];
                    u32x4 w; w.x = pk2(a[0], a[1]); w.y = pk2(a[2], a[3]); w.z = pk2(c[0], c[1]); w.w = pk2(c[2], c[3]);
                    *(u32x4*)(Kr + (size_t)row * 256 + h * 32 + 8 * fq) = w;
                }
            }
        }
    }
};
__device__ __forceinline__ void phase_knorm(const Params& p, int l) {
    const int tid_ = opaque_tid(), lane = tid_ & 63, gw = blockIdx.x * 8 + (tid_ >> 6), NW = gridDim.x * 8;
    bf16_t* Kn = (bf16_t*)(p.ws + WS_ACT); bf16_t* Kr = Kn + (size_t)KRPAD * 512;
    const float* kn = p.k_norm + (size_t)l * DQK;
    const int c0 = (lane & 7) * 8;
    float gn[8];
#pragma unroll
    for (int j = 0; j < 8; ++j) gn[j] = kn[c0 + j];
    const f32x4 gr = *(const f32x4*)(kn + 64 + (lane & 7) * 4);
    constexpr int U = 4;
    for (int k0 = gw; k0 < KR; k0 += NW * U) {
        u32x4 raw[U]; float pe[U]; f32x4 pv[U];
#pragma unroll
        for (int u = 0; u < U; ++u) {
            int kr = k0 + u * NW; if (kr >= KR) kr = k0;
            const float* kpe = kpe_row(p, l, kr);
            pe[u] = kpe ? kpe[lane & 31] : 0.f;
            pv[u] = (f32x4){0.f, 0.f, 0.f, 0.f};
            if (kpe) pv[u] = *(const f32x4*)(kpe + (lane & 7) * 4);
            raw[u] = *(const u32x4*)(Kn + (size_t)kr * 512 + 8 * lane);
        }
        float sp[U], ss[U];
#pragma unroll
        for (int u = 0; u < U; ++u) { sp[u] = pe[u] * pe[u];
            const float v[8] = {bflo(raw[u].x), bfhi(raw[u].x), bflo(raw[u].y), bfhi(raw[u].y), bflo(raw[u].z), bfhi(raw[u].z), bflo(raw[u].w), bfhi(raw[u].w)};
            float s = 0.f;
#pragma unroll
            for (int j = 0; j < 8; ++j) s += v[j] * v[j];
            ss[u] = s; }
#pragma unroll
        for (int u = 0; u < U; ++u) { sp[u] = sum32(sp[u]); ss[u] += shx<1>(ss[u]); ss[u] += shx<2>(ss[u]); ss[u] += shx<4>(ss[u]); }
#pragma unroll
        for (int u = 0; u < U; ++u) {
            const int kr = k0 + u * NW;
            if (kr < KR) {
                const float v[8] = {bflo(raw[u].x), bfhi(raw[u].x), bflo(raw[u].y), bfhi(raw[u].y), bflo(raw[u].z), bfhi(raw[u].z), bflo(raw[u].w), bfhi(raw[u].w)};
                const float rs = rsqrtf((ss[u] + sp[u]) * (1.f / DQK) + EPS);
                u32x4 o; o.x = pk2(v[0] * rs * gn[0], v[1] * rs * gn[1]); o.y = pk2(v[2] * rs * gn[2], v[3] * rs * gn[3]);
                o.z = pk2(v[4] * rs * gn[4], v[5] * rs * gn[5]); o.w = pk2(v[6] * rs * gn[6], v[7] * rs * gn[7]);
                *(u32x4*)(Kn + (size_t)kr * 512 + 8 * lane) = o;
                const f32x4 q = pv[u] * rs * gr;
                u32x2 w; w.x = pk2(q.x, q.y); w.y = pk2(q.z, q.w);
                *(u32x2*)(Kr + (size_t)kr * 256 + 4 * lane) = w;
            }
        }
    }
}

constexpr int KROW = 208, VROW = 144, KT_BYTES = 64 * KROW, VT_BYTES = 64 * VROW, ATT_BUF = KT_BYTES + VT_BYTES;

__device__ __forceinline__ size_t vt_off(int dvrow, int kr) { return ((size_t)(kr >> 6) * 512 + dvrow) * 64 + (kr & 63); }
__device__ __forceinline__ void q_prologue(const Params& p, int l, int qrow, int pos, int h, int hf, int lane, bf16x8 (&qf)[6]) {
    const bf16_t* qraw = (const bf16_t*)(p.ws + WS_QRAW);
    const float* qn = p.q_norm + (size_t)l * DQK;
    const bf16_t* qp = qraw + (size_t)qrow * 768 + h * DQK + 8 * hf;
    float v[6][8];
#pragma unroll
    for (int s = 0; s < 6; ++s) { const u32x4 raw = *(const u32x4*)(qp + 16 * s);
        v[s][0] = bflo(raw.x); v[s][1] = bfhi(raw.x); v[s][2] = bflo(raw.y); v[s][3] = bfhi(raw.y); v[s][4] = bflo(raw.z); v[s][5] = bfhi(raw.z); v[s][6] = bflo(raw.w); v[s][7] = bfhi(raw.w); }
#pragma unroll
    for (int e = 0; e < 8; ++e) { float c, s; rope_cs(pos, 8 * hf + e, c, s); const float x1 = v[4][e], x2 = v[5][e]; v[4][e] = x1 * c - x2 * s; v[5][e] = x1 * s + x2 * c; }
    float ss = 0.f;
#pragma unroll
    for (int s = 0; s < 6; ++s)
#pragma unroll
        for (int e = 0; e < 8; ++e) ss += v[s][e] * v[s][e];
    ss += shx32(ss, lane);
    const float rs = rsqrtf(ss * (1.f / DQK) + EPS) * 0.14724444602590306f;
#pragma unroll
    for (int s = 0; s < 6; ++s) { const float* g = qn + 16 * s + 8 * hf; u32x4 w;
        w.x = pk2(v[s][0] * rs * g[0], v[s][1] * rs * g[1]); w.y = pk2(v[s][2] * rs * g[2], v[s][3] * rs * g[3]);
        w.z = pk2(v[s][4] * rs * g[4], v[s][5] * rs * g[5]); w.w = pk2(v[s][6] * rs * g[6], v[s][7] * rs * g[7]);
        qf[s] = __builtin_bit_cast(bf16x8, w); }
}
template <bool MASKED>
__device__ __forceinline__ void attn_step(const bf16x8 (&ka)[2][6], const bf16x8 (&va)[2][4], const bf16x8 (&qf)[6], int nvalid, int lane, f32x16& o0, f32x16& o1, float& mrun, float& lsum) {
    f32x16 s0, s1;
#pragma unroll
    for (int i = 0; i < 16; ++i) { s0[i] = 0.f; s1[i] = 0.f; }
#pragma unroll
    for (int s = 0; s < 6; ++s) { s0 = __builtin_amdgcn_mfma_f32_32x32x16_bf16(ka[0][s], qf[s], s0, 0, 0, 0); s1 = __builtin_amdgcn_mfma_f32_32x32x16_bf16(ka[1][s], qf[s], s1, 0, 0, 0); }
    if (MASKED) {
#pragma unroll
        for (int i = 0; i < 16; ++i) { if (16 * (i >> 3) >= nvalid) s0[i] = -INFINITY; if (32 + 16 * (i >> 3) >= nvalid) s1[i] = -INFINITY; }
    }
    float mx = fmaxf(fmaxf(s0[0], s0[1]), s0[2]);
#pragma unroll
    for (int i = 3; i < 15; i += 2) mx = fmaxf(fmaxf(mx, s0[i]), s0[i + 1]);
    mx = fmaxf(mx, s0[15]);
#pragma unroll
    for (int i = 0; i < 16; i += 2) mx = fmaxf(fmaxf(mx, s1[i]), s1[i + 1]);
    if (__builtin_amdgcn_ballot_w64(mx > mrun + 8.0f) != 0ull) {
        mx = fmaxf(mx, shx32(mx, lane));
        const float mnew = fmaxf(mrun, mx);
        const float alpha = __builtin_amdgcn_exp2f(mrun - mnew);
        mrun = mnew; lsum *= alpha;
#pragma unroll
        for (int i = 0; i < 16; ++i) { o0[i] *= alpha; o1[i] *= alpha; }
    }
    {
        const f32x2 m2 = {mrun, mrun}; f32x2 acc2 = {0.f, 0.f};
#pragma unroll
        for (int i = 0; i < 16; i += 2) {
            f32x2 a = (f32x2){s0[i], s0[i + 1]} - m2, c = (f32x2){s1[i], s1[i + 1]} - m2;
            a.x = __builtin_amdgcn_exp2f(a.x); a.y = __builtin_amdgcn_exp2f(a.y); c.x = __builtin_amdgcn_exp2f(c.x); c.y = __builtin_amdgcn_exp2f(c.y);
            acc2 = acc2 + a; acc2 = acc2 + c;
            s0[i] = a.x; s0[i + 1] = a.y; s1[i] = c.x; s1[i + 1] = c.y;
        }
        lsum += acc2.x + acc2.y;
    }
    bf16x8 pf[4];
    { u32x4 w;
      w.x = pk2(s0[0], s0[1]); w.y = pk2(s0[2], s0[3]); w.z = pk2(s0[4], s0[5]); w.w = pk2(s0[6], s0[7]); pf[0] = __builtin_bit_cast(bf16x8, w);
      w.x = pk2(s0[8], s0[9]); w.y = pk2(s0[10], s0[11]); w.z = pk2(s0[12], s0[13]); w.w = pk2(s0[14], s0[15]); pf[1] = __builtin_bit_cast(bf16x8, w);
      w.x = pk2(s1[0], s1[1]); w.y = pk2(s1[2], s1[3]); w.z = pk2(s1[4], s1[5]); w.w = pk2(s1[6], s1[7]); pf[2] = __builtin_bit_cast(bf16x8, w);
      w.x = pk2(s1[8], s1[9]); w.y = pk2(s1[10], s1[11]); w.z = pk2(s1[12], s1[13]); w.w = pk2(s1[14], s1[15]); pf[3] = __builtin_bit_cast(bf16x8, w); }
#pragma unroll
    for (int ks = 0; ks < 4; ++ks) { o0 = __builtin_amdgcn_mfma_f32_32x32x16_bf16(va[0][ks], pf[ks], o0, 0, 0, 0); o1 = __builtin_amdgcn_mfma_f32_32x32x16_bf16(va[1][ks], pf[ks], o1, 0, 0, 0); }
}
__device__ __forceinline__ void attn_item(const Params& p, int l, LAS unsigned char* lds, int b, int h, int J) {
    const int tid = opaque_tid(), lane = tid & 63, wave = __builtin_amdgcn_readfirstlane(tid >> 6), r = lane & 31, hf = lane >> 5;
    const bf16_t* Kn = (const bf16_t*)(p.ws + WS_ACT); const bf16_t* Kr = Kn + (size_t)KRPAD * 512;
    const bf16_t* Vt = (const bf16_t*)p.out;
    bf16_t* mix = (bf16_t*)(p.ws + WS_MIX);
    const int i = 8 * J + wave, my_nt = (i >> 1) + 2, blk_nt = 4 * J + 5;
    const int qrow0 = b * TP + NMETA + 32 * i, kbase = b * TP;
    const bf16_t* gkn = Kn + ((size_t)kbase + (tid >> 3)) * 512 + h * 64 + (tid & 7) * 8;
    const bf16_t* gkr = Kr + ((size_t)kbase + ((tid & 255) >> 2)) * 256 + h * 32 + (tid & 3) * 8;
    const bf16_t* gvt = Vt + vt_off(h * 64 + (tid >> 3), kbase + (tid & 7) * 8);
    const int wkn = (tid >> 3) * KROW + (tid & 7) * 16, wkr = ((tid & 255) >> 2) * KROW + 128 + (tid & 3) * 16, wvt = KT_BYTES + (tid >> 3) * VROW + (tid & 7) * 16;
    const int pr = (r & ~12) | ((r & 4) << 1) | ((r & 8) >> 1);
    const int rk = pr * KROW + 16 * hf, rv = KT_BYTES + r * VROW + 16 * hf;
    const bool has_kr = tid < 256;
    u32x4 skn = *(const u32x4*)gkn, svt = *(const u32x4*)gvt, skr = {0u, 0u, 0u, 0u};
    if (has_kr) skr = *(const u32x4*)gkr;
    __builtin_amdgcn_sched_barrier(0);
    bf16x8 qf[6];
    q_prologue(p, l, qrow0 + r, NMETA + 32 * i + r, h, hf, lane, qf);
    *(LAS u32x4*)(lds + wkn) = skn; *(LAS u32x4*)(lds + wvt) = svt; if (has_kr) *(LAS u32x4*)(lds + wkr) = skr;
    __syncthreads();
    f32x16 o0, o1;
#pragma unroll
    for (int q = 0; q < 16; ++q) { o0[q] = 0.f; o1[q] = 0.f; }
    float mrun = -INFINITY, lsum = 0.f;
#pragma nounroll
    for (int j = 0; j < blk_nt; ++j) {
        LAS unsigned char* cur = lds + (j & 1) * ATT_BUF; LAS unsigned char* nxt = lds + ((j + 1) & 1) * ATT_BUF;
        const bool more = (j + 1) < blk_nt;
        if (more) { skn = *(const u32x4*)(gkn + (size_t)(j + 1) * 64 * 512); svt = *(const u32x4*)(gvt + (size_t)(j + 1) * 512 * 64); if (has_kr) skr = *(const u32x4*)(gkr + (size_t)(j + 1) * 64 * 256); }
        if (j < my_nt) {
            bf16x8 ka[2][6], va[2][4];
#pragma unroll
            for (int kb = 0; kb < 2; ++kb)
#pragma unroll
                for (int s = 0; s < 6; ++s) ka[kb][s] = *(const LAS bf16x8*)(cur + rk + kb * 32 * KROW + 32 * s);
#pragma unroll
            for (int dvb = 0; dvb < 2; ++dvb)
#pragma unroll
                for (int ks = 0; ks < 4; ++ks) va[dvb][ks] = *(const LAS bf16x8*)(cur + rv + dvb * 32 * VROW + 32 * ks);
            __builtin_amdgcn_sched_barrier(0);
            if (j < my_nt - 1) attn_step<false>(ka, va, qf, 64, lane, o0, o1, mrun, lsum); else attn_step<true>(ka, va, qf, 16, lane, o0, o1, mrun, lsum);
        }
        if (more) { *(LAS u32x4*)(nxt + wkn) = skn; *(LAS u32x4*)(nxt + wvt) = svt; if (has_kr) *(LAS u32x4*)(nxt + wkr) = skr; }
        __syncthreads();
    }
    lsum += shx32(lsum, lane);
    const float inv = 1.f / lsum;
    bf16_t* op = mix + (size_t)(qrow0 + r) * D + PW + h * DV + 4 * hf;
#pragma unroll
    for (int g = 0; g < 4; ++g) {
        u32x2 w; w.x = pk2(o0[4 * g] * inv, o0[4 * g + 1] * inv); w.y = pk2(o0[4 * g + 2] * inv, o0[4 * g + 3] * inv); *(u32x2*)(op + 8 * g) = w;
        w.x = pk2(o1[4 * g] * inv, o1[4 * g + 1] * inv); w.y = pk2(o1[4 * g + 2] * inv, o1[4 * g + 3] * inv); *(u32x2*)(op + 32 + 8 * g) = w;
    }
}
__device__ __forceinline__ void attn_sample(const Params& p, int l, LAS unsigned char* lds, int b, int h) {
    const int tid = opaque_tid(), lane = tid & 63, wave = __builtin_amdgcn_readfirstlane(tid >> 6), r = lane & 31, hf = lane >> 5;
    const bf16_t* Kn = (const bf16_t*)(p.ws + WS_ACT); const bf16_t* Kr = Kn + (size_t)KRPAD * 512;
    const bf16_t* Vt = (const bf16_t*)p.out;
    bf16_t* mix = (bf16_t*)(p.ws + WS_MIX);
    const int qrow0 = MP + b * DS, kbase = MP + b * SKP;
    bf16x8 qf[6];
    q_prologue(p, l, qrow0 + r, CROWS + r, h, hf, lane, qf);
    const int pr = (r & ~12) | ((r & 4) << 1) | ((r & 8) >> 1);
    const bf16_t* kn0 = Kn + ((size_t)kbase + pr) * 512 + h * 64 + 8 * hf;
    const bf16_t* kr0 = Kr + ((size_t)kbase + pr) * 256 + h * 32 + 8 * hf;
    const bf16_t* vt0 = Vt + vt_off(h * 64 + r, kbase) + 8 * hf;
    f32x16 o0, o1;
#pragma unroll
    for (int q = 0; q < 16; ++q) { o0[q] = 0.f; o1[q] = 0.f; }
    float mrun = -INFINITY, lsum = 0.f;
#pragma nounroll
    for (int j = wave; j < 65; j += 8) {
        const bf16_t* knp = kn0 + (size_t)j * 64 * 512; const bf16_t* krp = kr0 + (size_t)j * 64 * 256; const bf16_t* vtp = vt0 + (size_t)j * 512 * 64;
        bf16x8 ka[2][6], va[2][4];
#pragma unroll
        for (int kb = 0; kb < 2; ++kb) {
#pragma unroll
            for (int s = 0; s < 4; ++s) ka[kb][s] = *(const bf16x8*)(knp + (size_t)kb * 32 * 512 + 16 * s);
#pragma unroll
            for (int s = 0; s < 2; ++s) ka[kb][4 + s] = *(const bf16x8*)(krp + (size_t)kb * 32 * 256 + 16 * s);
        }
#pragma unroll
        for (int dvb = 0; dvb < 2; ++dvb)
#pragma unroll
            for (int ks = 0; ks < 4; ++ks) va[dvb][ks] = *(const bf16x8*)(vtp + (size_t)dvb * 32 * 64 + 16 * ks);
        if (j < 64) attn_step<false>(ka, va, qf, 64, lane, o0, o1, mrun, lsum); else attn_step<true>(ka, va, qf, 48, lane, o0, o1, mrun, lsum);
    }
    lsum += shx32(lsum, lane);
    LAS float* LO = (LAS float*)lds; LAS float* LM = LO + 8 * 32 * 64; LAS float* LL = LM + 8 * 64;
#pragma unroll
    for (int q = 0; q < 16; ++q) { LO[(wave * 32 + q) * 64 + lane] = o0[q]; LO[(wave * 32 + 16 + q) * 64 + lane] = o1[q]; }
    LM[wave * 64 + lane] = mrun; LL[wave * 64 + lane] = lsum;
    __syncthreads();
    float mm = LM[lane];
#pragma unroll
    for (int w = 1; w < 8; ++w) mm = fmaxf(mm, LM[w * 64 + lane]);
    float den = 0.f; float acc4[4] = {0.f, 0.f, 0.f, 0.f};
#pragma unroll
    for (int w = 0; w < 8; ++w) { const float f = __builtin_amdgcn_exp2f(LM[w * 64 + lane] - mm); den += f * LL[w * 64 + lane];
#pragma unroll
        for (int e = 0; e < 4; ++e) acc4[e] += f * LO[(w * 32 + 4 * wave + e) * 64 + lane]; }
    const float inv = 1.f / den;
    bf16_t* op = mix + (size_t)(qrow0 + r) * D + PW + h * DV + 32 * (wave >> 2) + 8 * (wave & 3) + 4 * hf;
    u32x2 wv; wv.x = pk2(acc4[0] * inv, acc4[1] * inv); wv.y = pk2(acc4[2] * inv, acc4[3] * inv); *(u32x2*)op = wv;
    __syncthreads();
}
__device__ __forceinline__ void attn_meta(const Params& p, int l, int b, int h, int qi) {
    const int lane = opaque_tid() & 63;
    const bf16_t* qraw = (const bf16_t*)(p.ws + WS_QRAW);
    const bf16_t* Kn = (const bf16_t*)(p.ws + WS_ACT); const bf16_t* Kr = Kn + (size_t)KRPAD * 512;
    const bf16_t* Vt = (const bf16_t*)p.out;
    bf16_t* mix = (bf16_t*)(p.ws + WS_MIX);
    const float* qn = p.q_norm + (size_t)l * DQK;
    const int row = b * TP + qi, kbase = b * TP;
    const bf16_t* qp = qraw + (size_t)row * 768 + h * DQK;
    float v0 = bflo((unsigned)qp[lane]), v1 = bflo((unsigned)qp[64 + (lane & 31)]);
    {
        float c, s; rope_cs(qi, lane & 15, c, s);
        const float other = shx<16>(v1);
        v1 = (lane & 16) ? (other * s + v1 * c) : (v1 * c - other * s);
    }
    float ss = v0 * v0 + (lane < 32 ? v1 * v1 : 0.f);
    ss = wave_sum(ss, lane);
    const float rs = rsqrtf(ss * (1.f / DQK) + EPS) * 0.14724444602590306f;
    v0 *= rs * qn[lane]; v1 = (lane < 32) ? v1 * rs * qn[64 + (lane & 31)] : 0.f;
    float sc[16]; float mx = -INFINITY;
#pragma unroll
    for (int kk = 0; kk < 16; ++kk) {
        float part = v0 * bflo((unsigned)Kn[((size_t)kbase + kk) * 512 + h * 64 + lane]) + v1 * bflo((unsigned)Kr[((size_t)kbase + kk) * 256 + h * 32 + (lane & 31)]);
        sc[kk] = wave_sum(part, lane); mx = fmaxf(mx, sc[kk]);
    }
    float den = 0.f, acc = 0.f;
    const bf16_t* vp = Vt + vt_off(h * 64 + lane, kbase);
#pragma unroll
    for (int kk = 0; kk < 16; ++kk) { const float pw = __builtin_amdgcn_exp2f(sc[kk] - mx); den += pw; acc += pw * bflo((unsigned)vp[kk]); }
    mix[(size_t)row * D + PW + h * DV + lane] = (bf16_t)(pk2(acc / den, 0.f) & 0xffffu);
}
__device__ __forceinline__ void phase_attn(const Params& p, int l, LAS unsigned char* lds) {
    const int wave = __builtin_amdgcn_readfirstlane(opaque_tid() >> 6), c = blockIdx.x, G = gridDim.x;
    if (G == 256) {
        const int x = c & 7, ci = c >> 3;
        for (int k = 0; k < 8; ++k) { const int bh = 8 * k + x, J = (k & 1) ? 31 - ci : ci; attn_item(p, l, lds, bh >> 3, bh & 7, J); }
    } else {
        for (int k = 0; ; ++k) {
            const int base = k * G; if (base >= 2048) break;
            const int e = (k & 1) ? base + (G - 1 - c) : base + c;
            if (e < 2048) { const int J = 31 - (e >> 6), bh = e & 63; attn_item(p, l, lds, bh >> 3, bh & 7, J); }
        }
    }
    for (int u = c; u < DB * NH; u += G) attn_sample(p, l, lds, u >> 3, u & 7);
    for (int u = c * 8 + wave; u < NB * NH * NMETA; u += G * 8) { const int qi = u & 15, h = (u >> 4) & 7, b = u >> 7; attn_meta(p, l, b, h, qi); }
}

#define XB_TMO      128
#define XB_XCNT(j)  (256  + 64 * (j))
#define XB_XSUB(j)  (1280 + 64 * (j))
#define XB_XGEN(j)  (2304 + 64 * (j))
#define XB_TOP      3328
#define XB_TOPGEN   3392
#define XCD_BAR_WORDS 3456
#define XB_SPIN_CAP (1u << 20)
__device__ __forceinline__ unsigned xb_ld(unsigned* p)              { return __hip_atomic_load(p, __ATOMIC_RELAXED, __HIP_MEMORY_SCOPE_AGENT); }
__device__ __forceinline__ unsigned xb_add(unsigned* p, unsigned v) { return __hip_atomic_fetch_add(p, v, __ATOMIC_RELAXED, __HIP_MEMORY_SCOPE_AGENT); }
__device__ __forceinline__ unsigned xb_xcc_id() { return (unsigned)__builtin_amdgcn_s_getreg((3 << 11) | 20) & 0xFu; }
#define XB_SPIN(cond, bar) do { unsigned _sp = 0; while (cond) { __builtin_amdgcn_s_sleep(1); \
    if ((++_sp & 255u) == 0u) { if (xb_ld(&(bar)[XB_TMO])) break; if (_sp > XB_SPIN_CAP) { atomicAdd(&(bar)[XB_TMO], 1u); break; } } } } while (0)
struct XcdBarrier { unsigned* bar; unsigned x; volatile LAS unsigned* st; };
__device__ __forceinline__ XcdBarrier xcd_barrier_post(unsigned* bar, volatile LAS unsigned* st) {
    XcdBarrier b; b.bar = bar; b.x = xb_xcc_id(); b.st = st;
    if (threadIdx.x == 0) (void)xb_add(&bar[XB_XCNT(b.x)], 1u);
    return b;
}
__device__ __forceinline__ void xcd_barrier_complete(unsigned* bar, unsigned x, unsigned& nloc, unsigned& nx) {
    const unsigned G = gridDim.x * gridDim.y * gridDim.z;
    unsigned sum, cnt, mine, sp = 0u;
    for (;;) {
        sum = 0u; cnt = 0u; mine = 0u;
#pragma unroll
        for (unsigned j = 0; j < 16; ++j) { const unsigned c = xb_ld(&bar[XB_XCNT(j)]); sum += c; cnt += (c > 0u) ? 1u : 0u; mine = (j == x) ? c : mine; }
        if (sum == G) break;
        __builtin_amdgcn_s_sleep(1);
        if ((++sp & 255u) == 0u) { if (xb_ld(&bar[XB_TMO])) break; if (sp > XB_SPIN_CAP) { atomicAdd(&bar[XB_TMO], 1u); break; } }
    }
    nloc = mine > 0u ? mine : 1u; nx = cnt > 0u ? cnt : 1u;
}
__device__ __forceinline__ void xcd_barrier(const XcdBarrier& b) {
    asm volatile("s_waitcnt vmcnt(0)" ::: "memory");
    __syncthreads();
    if (threadIdx.x == 0) {
        unsigned* bar = b.bar;
        __builtin_amdgcn_s_waitcnt(0);
        unsigned nloc = b.st[0], nx = b.st[1];
        if (nloc == 0u) { xcd_barrier_complete(bar, b.x, nloc, nx); b.st[0] = nloc; b.st[1] = nx; }
        const unsigned old = xb_add(&bar[XB_XSUB(b.x)], 1u);
        const unsigned gen = old / nloc;
        if (old + 1u == (gen + 1u) * nloc) {
            __builtin_amdgcn_fence(__ATOMIC_RELEASE, "agent");
            asm volatile("s_waitcnt vmcnt(0)" ::: "memory");
            const unsigned og = xb_add(&bar[XB_TOP], 1u);
            const unsigned tg = og / nx;
            if (og + 1u == (tg + 1u) * nx) xb_add(&bar[XB_TOPGEN], 1u);
            else XB_SPIN(xb_ld(&bar[XB_TOPGEN]) == tg, bar);
            __builtin_amdgcn_fence(__ATOMIC_ACQUIRE, "agent");
            xb_add(&bar[XB_XGEN(b.x)], 1u);
            asm volatile("s_waitcnt vmcnt(0)" ::: "memory");
        } else {
            XB_SPIN(xb_ld(&bar[XB_XGEN(b.x)]) == gen, bar);
            __builtin_amdgcn_fence(__ATOMIC_ACQUIRE, "agent");
            asm volatile("s_waitcnt vmcnt(0)" ::: "memory");
        }
    }
    __syncthreads();
}

__global__ void __launch_bounds__(512, 2) fwd_mega(Params p0) {
    extern __shared__ __attribute__((aligned(16))) unsigned char shm[];
    LAS unsigned char* lds = (LAS unsigned char*)shm;
    cg::grid_group grid = cg::this_grid();
    volatile LAS unsigned* xst = (volatile LAS unsigned*)(lds + pg8::STAGE_BYTES);
    if (threadIdx.x == 0) { xst[0] = 0u; xst[1] = 0u; }
    __syncthreads();
    const XcdBarrier xb = xcd_barrier_post((unsigned*)(p0.ws + WS_BAR), xst);
    phase_prep(p0, lds, 0, 0xff, (int)blockIdx.x, (int)gridDim.x);
#pragma nounroll
    for (int li = 0; li < 2; ++li) {
        Params p = p0; int l = li;
        { size_t zw = 0, zo = 0; asm volatile("" : "+s"(zw), "+s"(zo), "+s"(l)); p.ws = p0.ws + zw; p.out = p0.out + zo; }
        bf16_t* wts = (bf16_t*)(p.ws + WS_WTS);
        bf16_t* xrb = (bf16_t*)(p.ws + WS_XRES);
        bf16_t* hbuf = (bf16_t*)(p.ws + WS_HBUF);
        bf16_t* mix = (bf16_t*)(p.ws + WS_MIX);
        bf16_t* act = (bf16_t*)(p.ws + WS_ACT);
        bf16_t* qraw = (bf16_t*)(p.ws + WS_QRAW);
        bf16_t* Kn = act;
        bf16_t* Vt = (bf16_t*)p.out;
        bf16_t* qa = Vt + (size_t)KRPAD * 512;
        const bf16_t* wl = wts + (size_t)l * W_LAYER;
        float* slot = (float*)(p.ws + WS_SLOT); const float* rs = (const float*)(p.ws + WS_RS);
        if (l == 0) { phase_rmsnorm_first(p); grid.sync(); }
        run_gemm(lds, xrb, wl + W_IN, MPAD, DINP, D, pg8::EpiBf16S<DINP>{act, rs}, 0);
        if (l == 0) {
            const int G = gridDim.x, extra = ((MPAD / 256) * (DINP / 256)) % G, c = blockIdx.x;
            if (c >= extra) phase_cacheconv(p, 0, c - extra, G - extra);
        }
        xcd_barrier(xb);
        phase_postin(p, l);
        xcd_barrier(xb);
        run_gemm(lds, qa, wl + W_UQ, MPAD, 768, QRK, pg8::EpiBf16<768>{qraw}, 0);
        run_gemm(lds, hbuf, wl + W_UK, KRPAD, 512, KVR, EpiKnorm{p, l}, 256 - 15);
        run_gemm(lds, wl + W_UV, hbuf, 512, KRPAD, KVR, pg8::EpiVt{Vt}, 256 - 33);
        xcd_barrier(xb);
        phase_attn(p, l, lds);
        xcd_barrier(xb);
        if (l == 0) run_gemm(lds, mix, wl + W_O, MPAD, D, D, pg8::EpiResInitB{xrb, p.meta, p.x_prompt, p.x_sample, slot}, 0);
        else run_gemm(lds, mix, wl + W_O, MPAD, D, D, pg8::EpiResAddB{xrb, slot}, 0);
        xcd_barrier(xb);
        phase_rowstat(p);
        xcd_barrier(xb);
        run_gemm(lds, xrb, wl + W_GU, MPAD, 2 * DFF, D, pg8::EpiSwiglu{act, rs}, 0);
        xcd_barrier(xb);
        if (l == 0) {
            run_gemm(lds, act, wl + W_DN, MPAD, D, DFF, pg8::EpiResAddB{xrb, slot}, 0);
            { int G = gridDim.x, c = blockIdx.x; asm volatile("" : "+s"(G), "+s"(c));
              const int extra = ((MPAD / 256) * (D / 256)) % G; if (c >= extra) { phase_cacheconv(p, 1, c - extra, G - extra); phase_prep(p, lds, 1, 0xff, c - extra, G - extra); } }
            xcd_barrier(xb); phase_rowstat(p); xcd_barrier(xb); }
        else { run_gemm(lds, act, wl + W_DN, MPAD, D, DFF, pg8::EpiFinalB{xrb, p.out}, 0); xcd_barrier(xb); }
    }
}

extern "C" void kernel_launch(void* const* d_in, const int* in_sizes, int n_in, void* d_out, int out_size, void* d_ws, size_t ws_size, hipStream_t stream) {
    constexpr int LDS_BYTES = pg8::STAGE_BYTES + 16;
    static int grid = 0;
    if (grid == 0) {
        if (n_in != 22 || (size_t)out_size != O_END || ws_size < WS_TOTAL) { fprintf(stderr, "kernel_launch: unexpected sizes n_in %d out %d ws %zu (need %zu)\n", n_in, out_size, ws_size, (size_t)WS_TOTAL); grid = -1; return; }
        int dev = 0, cus = 0, per_cu = 0;
        if (hipGetDevice(&dev) != hipSuccess || hipDeviceGetAttribute(&cus, hipDeviceAttributeMultiprocessorCount, dev) != hipSuccess) { grid = -1; return; }
        if (hipFuncSetAttribute((const void*)fwd_mega, hipFuncAttributeMaxDynamicSharedMemorySize, LDS_BYTES) != hipSuccess) { fprintf(stderr, "hipFuncSetAttribute failed\n"); grid = -1; return; }
        if (hipOccupancyMaxActiveBlocksPerMultiprocessor(&per_cu, (const void*)fwd_mega, 512, LDS_BYTES) != hipSuccess || per_cu < 1) fprintf(stderr, "occupancy query: %d\n", per_cu);
        (void)hipGetLastError();
        grid = cus;
    }
    if (grid < 0) return;
    if (hipMemsetAsync((char*)d_ws + WS_BAR, 0, 3456 * 4, stream) != hipSuccess) { fprintf(stderr, "memset of barrier words failed\n"); return; }
    Params p{};
    const float** f = (const float**)&p;
    for (int i = 0; i < 22; ++i) f[i] = (const float*)d_in[i];
    p.out = (float*)d_out; p.ws = (unsigned char*)d_ws;
    void* args[] = {&p};
    hipError_t e = hipLaunchCooperativeKernel((void*)fwd_mega, dim3(grid), dim3(512), args, LDS_BYTES, stream);
    if (e != hipSuccess) fprintf(stderr, "cooperative launch failed: %s (grid %d)\n", hipGetErrorString(e), grid);
}
```

```cpp
#include <hip/hip_runtime.h>
#include <hip/hip_cooperative_groups.h>
#include <cstdio>
#include <cstdint>
namespace cg = cooperative_groups;

#define LAS __attribute__((address_space(3)))
typedef unsigned short bf16_t;
typedef short bf16x8 __attribute__((ext_vector_type(8)));
typedef float f32x4 __attribute__((ext_vector_type(4)));
typedef float f32x2 __attribute__((ext_vector_type(2)));
typedef float f32x16 __attribute__((ext_vector_type(16)));
typedef unsigned u32x4 __attribute__((ext_vector_type(4)));
typedef unsigned u32x2 __attribute__((ext_vector_type(2)));
typedef __bf16 bf16x2_t __attribute__((ext_vector_type(2)));

constexpr int D = 1024, NB = 8, SEQ = 8192, NMETA = 16, TP = SEQ + NMETA, MP = NB * TP;
constexpr int DB = 32, DS = 32, MS = DB * DS, M = MP + MS, MPAD = 66816;
constexpr int CROWS = 4112, SK = CROWS + DS, SKP = 4160;
constexpr int KR = MP + DB * SKP, KRPAD = 198912;
constexpr int DIN = 1184, DINP = 1280, QRK = 384, KVR = 256, DROPE = 32, NH = 8, DQK = 96, DNOPE = 64, DV = 64, DFF = 2816, PW = 512;
constexpr float EPS = 1e-6f;
static_assert(MPAD % 256 == 0 && MPAD >= M && KRPAD % 256 == 0 && KRPAD >= KR, "pad");

constexpr size_t W_IN = 0, W_UQ = W_IN + (size_t)DINP * D, W_UK = W_UQ + (size_t)768 * QRK, W_UV = W_UK + (size_t)512 * KVR, W_O = W_UV + (size_t)512 * KVR,
                 W_GU = W_O + (size_t)D * D, W_DN = W_GU + (size_t)2 * DFF * D, W_LAYER = W_DN + (size_t)D * DFF;
constexpr size_t WS_XRES = 0, WS_WTS = WS_XRES + (size_t)MPAD * D * 4, WS_MIX = WS_WTS + 2 * W_LAYER * 2, WS_HBUF = WS_MIX + (size_t)MPAD * D * 2,
                 WS_ACT = WS_HBUF + (size_t)MPAD * D * 2, WS_QRAW = WS_ACT + (size_t)MPAD * DFF * 2, WS_END = WS_QRAW + (size_t)MPAD * 768 * 2;
constexpr size_t WS_BAR = (WS_END + 255) / 256 * 256, WS_SSK = WS_BAR + 3456 * 4 + 256, WS_TOTAL = WS_SSK + (size_t)KRPAD * 4;
static_assert(WS_TOTAL <= (size_t)1 << 30, "workspace");
constexpr size_t WS_SLOT = WS_HBUF + (size_t)KRPAD * 256 * 2, WS_RS = WS_SLOT + (size_t)MPAD * 16 * 4;
static_assert(WS_RS + (size_t)MPAD * 4 <= WS_HBUF + (size_t)MPAD * D * 2, "lat + row stats fit hbuf");
static_assert((size_t)MPAD * DINP * 4 <= (size_t)MPAD * DFF * 2, "z fits act");
static_assert((size_t)KRPAD * 768 * 2 <= (size_t)MPAD * DFF * 2, "Kn+Kr fits act");
static_assert((size_t)KRPAD * 512 * 2 + (size_t)MPAD * QRK * 2 <= (size_t)NB * SEQ * D * 4, "Vt+qa fit y_prompt");
constexpr size_t O_YP = 0, O_YS = O_YP + (size_t)NB * SEQ * D, O_LATP = O_YS + (size_t)MS * D, O_KPEP = O_LATP + (size_t)2 * MP * KVR, O_POOLP = O_KPEP + (size_t)2 * MP * DROPE,
                 O_LATS = O_POOLP + (size_t)2 * NB * 15 * PW, O_KPES = O_LATS + (size_t)2 * MS * KVR, O_POOLS = O_KPES + (size_t)2 * MS * DROPE, O_END = O_POOLS + (size_t)2 * DB * 15 * PW;

__device__ const double INVF[16] = {1.0, 0.5623413251903491, 0.31622776601683794, 0.1778279410038923, 0.1, 0.05623413251903491, 0.03162277660168379, 0.01778279410038923,
                                    0.01, 0.005623413251903491, 0.0031622776601683794, 0.0017782794100389228, 0.001, 0.0005623413251903491, 0.00031622776601683794, 0.00017782794100389227};

struct Params {
    const float *x_prompt, *x_sample, *cache_latent, *cache_krope, *state_pool, *meta, *norm_mix, *w_in, *q_a_norm, *w_uq, *kv_a_norm, *w_uk, *w_uv, *q_norm, *k_norm,
        *w_pool, *pool_scale, *w_o, *norm_ffn, *w_gate, *w_up, *w_down;
    float* out; unsigned char* ws;
};

__device__ __forceinline__ unsigned pk2(float a, float b) { f32x2 v = {a, b}; bf16x2_t r = __builtin_convertvector(v, bf16x2_t); return __builtin_bit_cast(unsigned, r); }
__device__ __forceinline__ float bflo(unsigned u) { return __uint_as_float(u << 16); }
__device__ __forceinline__ float bfhi(unsigned u) { return __uint_as_float(u & 0xffff0000u); }
__device__ __forceinline__ f32x2 ld2(const bf16_t* p) { const unsigned u = *(const unsigned*)p; return (f32x2){bflo(u), bfhi(u)}; }
__device__ __forceinline__ f32x4 ld4(const bf16_t* p) { const u32x2 u = *(const u32x2*)p; return (f32x4){bflo(u.x), bfhi(u.x), bflo(u.y), bfhi(u.y)}; }
template <int MASK> __device__ __forceinline__ float shx(float v) {
    static_assert(MASK >= 1 && MASK < 32, "swizzle mask");
    return __int_as_float(__builtin_amdgcn_ds_swizzle(__float_as_int(v), 0x1f | (MASK << 10)));
}
__device__ __forceinline__ float shx32(float v, int lane) { return __int_as_float(__builtin_amdgcn_ds_bpermute((lane ^ 32) << 2, __float_as_int(v))); }
__device__ __forceinline__ float sum32(float v) { v += shx<1>(v); v += shx<2>(v); v += shx<4>(v); v += shx<8>(v); v += shx<16>(v); return v; }
__device__ __forceinline__ float wave_sum(float v, int lane) { v = sum32(v); return v + shx32(v, lane); }
__device__ __forceinline__ void rope_cs(int pos, int i, float& c, float& s) {
    const double rev = (double)pos * INVF[i] * 0.15915494309189535;
    const float fr = (float)(rev - floor(rev));
    c = __builtin_amdgcn_cosf(fr); s = __builtin_amdgcn_sinf(fr);
}

namespace pg8 {
constexpr int BM = 256, BK = 64, HALF = 128, HTB = HALF * BK * 2, STAGE_BYTES = 8 * HTB, NXCD = 8, WGM = 8;
__host__ __device__ __forceinline__ int lds_byte(int r, int c) { const int st = (r >> 4) * 2 + (c >> 5), rr = r & 15, cc = c & 31, ob = rr * 64 + cc * 2; return st * 1024 + (ob ^ (((ob >> 9) & 1) << 5)); }
__host__ __device__ __forceinline__ void stage_rc(int b, int& R, int& C) { const int st = b / 1024, sb = b % 1024, swz = sb ^ (((sb >> 9) & 1) << 5); R = (st >> 1) * 16 + swz / 64; C = (st & 1) * 32 + (swz % 64) / 2; }
__host__ __device__ __forceinline__ int perm32(int rho) { const int n = rho >> 4, i = rho & 15; return 8 * (i >> 2) + 4 * n + (i & 3); }
struct Unit { int pm, pn; };
struct Gemm { const bf16_t* A; const bf16_t* Bt; int M, N, K; };
struct StaticOrder {
    int nM, nN, nwg, G, c;
    __host__ __device__ void init(int M_, int N_, int G_, int c_) { nM = M_ / BM; nN = N_ / BM; nwg = nM * nN; G = G_; c = c_; }
    __host__ __device__ bool next(int i, Unit& u) const {
        const long L = (long)i * G + c; if (L >= nwg) return false;
        int wgid = (int)L; { const int q = nwg / NXCD, r = nwg % NXCD, xcd = wgid % NXCD, off = wgid / NXCD; wgid = (xcd < r ? xcd * (q + 1) : r * (q + 1) + (xcd - r) * q) + off; }
        const int nig = WGM * nN, gid = wgid / nig, fm = gid * WGM, gsz = (nM - fm) < WGM ? (nM - fm) : WGM;
        u.pm = fm + ((wgid % nig) % gsz); u.pn = (wgid % nig) / gsz; return true;
    }
    __device__ __forceinline__ void a_ready(const Unit&) const {}
    __device__ __forceinline__ void done(const Unit&) const {}
};
__device__ __forceinline__ unsigned cvt_pk_bf16(float lo, float hi) { unsigned r; asm volatile("v_cvt_pk_bf16_f32 %0, %1, %2" : "=v"(r) : "v"(lo), "v"(hi)); return r; }

struct EpiF32 {
    static constexpr bool PERM = false, AFTER_DRAIN = false;
    float* C; int ldc;
    __device__ __forceinline__ void operator()(const f32x4 (&acc)[2][2][4][2], const Unit& u, int wr, int wc, int fr, int fq) const {
        const int row0 = u.pm * BM + wr * 64 + fr, col0 = u.pn * BM + wc * 32 + 4 * fq;
#pragma unroll
        for (int ai = 0; ai < 2; ++ai)
#pragma unroll
            for (int m = 0; m < 4; ++m) { float* rowp = C + (size_t)(row0 + ai * HALF + m * 16) * ldc + col0;
#pragma unroll
                for (int bj = 0; bj < 2; ++bj)
#pragma unroll
                    for (int n = 0; n < 2; ++n) *(f32x4*)(rowp + bj * HALF + n * 16) = acc[ai][bj][m][n]; }
    }
};
struct EpiResAdd {
    static constexpr bool PERM = false, AFTER_DRAIN = false;
    float* C; int ldc;
    __device__ __forceinline__ void operator()(const f32x4 (&acc)[2][2][4][2], const Unit& u, int wr, int wc, int fr, int fq) const {
        const int row0 = u.pm * BM + wr * 64 + fr, col0 = u.pn * BM + wc * 32 + 4 * fq;
#pragma unroll
        for (int ai = 0; ai < 2; ++ai)
#pragma unroll
            for (int m = 0; m < 4; ++m) { float* rowp = C + (size_t)(row0 + ai * HALF + m * 16) * ldc + col0;
                f32x4 old[2][2];
#pragma unroll
                for (int bj = 0; bj < 2; ++bj)
#pragma unroll
                    for (int n = 0; n < 2; ++n) old[bj][n] = *(const f32x4*)(rowp + bj * HALF + n * 16);
#pragma unroll
                for (int bj = 0; bj < 2; ++bj)
#pragma unroll
                    for (int n = 0; n < 2; ++n) *(f32x4*)(rowp + bj * HALF + n * 16) = old[bj][n] + acc[ai][bj][m][n]; }
    }
};
struct EpiResInit {
    static constexpr bool PERM = false, AFTER_DRAIN = false;
    float* C; const float* meta; const float* xp; const float* xs;
    __device__ __forceinline__ void operator()(const f32x4 (&acc)[2][2][4][2], const Unit& u, int wr, int wc, int fr, int fq) const {
        const int row0 = u.pm * BM + wr * 64 + fr, col0 = u.pn * BM + wc * 32 + 4 * fq;
#pragma unroll
        for (int ai = 0; ai < 2; ++ai)
#pragma unroll
            for (int m = 0; m < 4; ++m) { const int r = row0 + ai * HALF + m * 16;
                if (r < M) {
                    const float* src;
                    if (r < MP) { const int b = r / TP, t = r - b * TP; src = (t < NMETA) ? meta + (size_t)t * D : xp + ((size_t)b * SEQ + (t - NMETA)) * D; }
                    else src = xs + (size_t)(r - MP) * D;
                    float* rowp = C + (size_t)r * D + col0; src += col0;
                    f32x4 old[2][2];
#pragma unroll
                    for (int bj = 0; bj < 2; ++bj)
#pragma unroll
                        for (int n = 0; n < 2; ++n) old[bj][n] = *(const f32x4*)(src + bj * HALF + n * 16);
#pragma unroll
                    for (int bj = 0; bj < 2; ++bj)
#pragma unroll
                        for (int n = 0; n < 2; ++n) *(f32x4*)(rowp + bj * HALF + n * 16) = old[bj][n] + acc[ai][bj][m][n];
                } }
    }
};
struct EpiFinal {
    static constexpr bool PERM = false, AFTER_DRAIN = false;
    const float* X; float* out;
    __device__ __forceinline__ void operator()(const f32x4 (&acc)[2][2][4][2], const Unit& u, int wr, int wc, int fr, int fq) const {
        const int row0 = u.pm * BM + wr * 64 + fr, col0 = u.pn * BM + wc * 32 + 4 * fq;
#pragma unroll
        for (int ai = 0; ai < 2; ++ai)
#pragma unroll
            for (int m = 0; m < 4; ++m) { const int r = row0 + ai * HALF + m * 16; float* dst = nullptr;
                if (r < MP) { const int b = r / TP, t = r - b * TP; if (t >= NMETA) dst = out + O_YP + ((size_t)b * SEQ + (t - NMETA)) * D; }
                else if (r < M) dst = out + O_YS + (size_t)(r - MP) * D;
                if (dst) { const float* xp = X + (size_t)r * D + col0;
#pragma unroll
                    for (int bj = 0; bj < 2; ++bj)
#pragma unroll
                        for (int n = 0; n < 2; ++n) *(f32x4*)(dst + col0 + bj * HALF + n * 16) = *(const f32x4*)(xp + bj * HALF + n * 16) + acc[ai][bj][m][n]; } }
    }
};
template <int LDC> struct EpiBf16S {
    static constexpr bool PERM = true, AFTER_DRAIN = false;
    static constexpr size_t ldc = LDC;
    bf16_t* O; const float* rs;
    __device__ __forceinline__ void operator()(const f32x4 (&acc)[2][2][4][2], const Unit& u, int wr, int wc, int fr, int fq) const {
        const int row0 = u.pm * BM + wr * 64 + fr, col0 = u.pn * BM + wc * 32 + 8 * fq;
        float sv[2][4];
#pragma unroll
        for (int ai = 0; ai < 2; ++ai)
#pragma unroll
            for (int m = 0; m < 4; ++m) sv[ai][m] = rs[row0 + ai * HALF + m * 16];
#pragma unroll
        for (int ai = 0; ai < 2; ++ai)
#pragma unroll
            for (int m = 0; m < 4; ++m) { const int row = row0 + ai * HALF + m * 16; const float s = sv[ai][m]; bf16_t* rowp = O + (size_t)row * ldc + col0;
#pragma unroll
                for (int bj = 0; bj < 2; ++bj) { const f32x4 v0 = acc[ai][bj][m][0] * s, v1 = acc[ai][bj][m][1] * s;
                    u32x4 w; w.x = cvt_pk_bf16(v0[0], v0[1]); w.y = cvt_pk_bf16(v0[2], v0[3]); w.z = cvt_pk_bf16(v1[0], v1[1]); w.w = cvt_pk_bf16(v1[2], v1[3]);
                    *(u32x4*)(rowp + bj * HALF) = w; } }
    }
};
template <int LDC> struct EpiBf16 {
    static constexpr bool PERM = true, AFTER_DRAIN = false;
    static constexpr size_t ldc = LDC;
    bf16_t* O;
    __device__ __forceinline__ void operator()(const f32x4 (&acc)[2][2][4][2], const Unit& u, int wr, int wc, int fr, int fq) const {
        const int row0 = u.pm * BM + wr * 64 + fr, col0 = u.pn * BM + wc * 32 + 8 * fq;
#pragma unroll
        for (int ai = 0; ai < 2; ++ai)
#pragma unroll
            for (int m = 0; m < 4; ++m) { bf16_t* rowp = O + (size_t)(row0 + ai * HALF + m * 16) * ldc + col0;
#pragma unroll
                for (int bj = 0; bj < 2; ++bj) { const f32x4 v0 = acc[ai][bj][m][0], v1 = acc[ai][bj][m][1];
                    u32x4 w; w.x = cvt_pk_bf16(v0[0], v0[1]); w.y = cvt_pk_bf16(v0[2], v0[3]); w.z = cvt_pk_bf16(v1[0], v1[1]); w.w = cvt_pk_bf16(v1[2], v1[3]);
                    *(u32x4*)(rowp + bj * HALF) = w; } }
    }
};
struct EpiVt {
    static constexpr bool PERM = true, AFTER_DRAIN = false;
    bf16_t* O;
    __device__ __forceinline__ void operator()(const f32x4 (&acc)[2][2][4][2], const Unit& u, int wr, int wc, int fr, int fq) const {
        const int row0 = u.pm * BM + wr * 64 + fr, col0 = u.pn * BM + wc * 32 + 8 * fq;
#pragma unroll
        for (int ai = 0; ai < 2; ++ai)
#pragma unroll
            for (int m = 0; m < 4; ++m) { const int row = row0 + ai * HALF + m * 16;
#pragma unroll
                for (int bj = 0; bj < 2; ++bj) { const int col = col0 + bj * HALF; const f32x4 v0 = acc[ai][bj][m][0], v1 = acc[ai][bj][m][1];
                    u32x4 w; w.x = cvt_pk_bf16(v0[0], v0[1]); w.y = cvt_pk_bf16(v0[2], v0[3]); w.z = cvt_pk_bf16(v1[0], v1[1]); w.w = cvt_pk_bf16(v1[2], v1[3]);
                    *(u32x4*)(O + ((size_t)(col >> 6) * 512 + row) * 64 + (col & 63)) = w; } }
    }
};
__device__ __forceinline__ float sq8(const u32x4 w) { return (bflo(w.x) * bflo(w.x) + bfhi(w.x) * bfhi(w.x)) + (bflo(w.y) * bflo(w.y) + bfhi(w.y) * bfhi(w.y)) + (bflo(w.z) * bflo(w.z) + bfhi(w.z) * bfhi(w.z)) + (bflo(w.w) * bflo(w.w) + bfhi(w.w) * bfhi(w.w)); }
struct EpiResAddB {
    static constexpr bool PERM = true, AFTER_DRAIN = false;
    bf16_t* X; float* slot;
    __device__ __forceinline__ void operator()(const f32x4 (&acc)[2][2][4][2], const Unit& u, int wr, int wc, int fr, int fq) const {
        const int row0 = u.pm * BM + wr * 64 + fr, col0 = u.pn * BM + wc * 32 + 8 * fq;
#pragma unroll
        for (int ai = 0; ai < 2; ++ai) {
            u32x4 o[4][2];
#pragma unroll
            for (int m = 0; m < 4; ++m)
#pragma unroll
                for (int bj = 0; bj < 2; ++bj) o[m][bj] = *(const u32x4*)(X + (size_t)(row0 + ai * HALF + m * 16) * D + col0 + bj * HALF);
#pragma unroll
            for (int m = 0; m < 4; ++m) { bf16_t* rowp = X + (size_t)(row0 + ai * HALF + m * 16) * D + col0;
                float ss = 0.f;
#pragma unroll
                for (int bj = 0; bj < 2; ++bj) { const f32x4 v0 = acc[ai][bj][m][0], v1 = acc[ai][bj][m][1]; const u32x4 q = o[m][bj];
                    u32x4 w; w.x = cvt_pk_bf16(bflo(q.x) + v0[0], bfhi(q.x) + v0[1]); w.y = cvt_pk_bf16(bflo(q.y) + v0[2], bfhi(q.y) + v0[3]);
                    w.z = cvt_pk_bf16(bflo(q.z) + v1[0], bfhi(q.z) + v1[1]); w.w = cvt_pk_bf16(bflo(q.w) + v1[2], bfhi(q.w) + v1[3]);
                    *(u32x4*)(rowp + bj * HALF) = w; ss += sq8(w); }
                ss += shx<16>(ss); ss += shx32(ss, fq * 16 + fr);
                if (fq == 0) slot[(size_t)(row0 + ai * HALF + m * 16) * 16 + 4 * u.pn + wc] = ss; }
        }
    }
};
struct EpiResInitB {
    static constexpr bool PERM = true, AFTER_DRAIN = false;
    bf16_t* X; const float* meta; const float* xp; const float* xs; float* slot;
    __device__ __forceinline__ void operator()(const f32x4 (&acc)[2][2][4][2], const Unit& u, int wr, int wc, int fr, int fq) const {
        const int row0 = u.pm * BM + wr * 64 + fr, col0 = u.pn * BM + wc * 32 + 8 * fq;
#pragma unroll
        for (int ai = 0; ai < 2; ++ai) {
            f32x4 o[4][2][2];
#pragma unroll
            for (int m = 0; m < 4; ++m) { int r = row0 + ai * HALF + m * 16; if (r >= M) r = 0;
                const float* src;
                if (r < MP) { const int b = r / TP, t = r - b * TP; src = (t < NMETA) ? meta + (size_t)t * D : xp + ((size_t)b * SEQ + (t - NMETA)) * D; }
                else src = xs + (size_t)(r - MP) * D;
                src += col0;
#pragma unroll
                for (int bj = 0; bj < 2; ++bj)
#pragma unroll
                    for (int n = 0; n < 2; ++n) o[m][bj][n] = *(const f32x4*)(src + bj * HALF + 4 * n); }
#pragma unroll
            for (int m = 0; m < 4; ++m) { const int r = row0 + ai * HALF + m * 16;
                float ss = 0.f;
                bf16_t* rowp = X + (size_t)r * D + col0;
#pragma unroll
                for (int bj = 0; bj < 2; ++bj) { const f32x4 v0 = acc[ai][bj][m][0] + o[m][bj][0], v1 = acc[ai][bj][m][1] + o[m][bj][1];
                    u32x4 w; w.x = cvt_pk_bf16(v0[0], v0[1]); w.y = cvt_pk_bf16(v0[2], v0[3]); w.z = cvt_pk_bf16(v1[0], v1[1]); w.w = cvt_pk_bf16(v1[2], v1[3]);
                    if (r < M) *(u32x4*)(rowp + bj * HALF) = w;
                    ss += sq8(w); }
                ss += shx<16>(ss); ss += shx32(ss, fq * 16 + fr);
                if (fq == 0 && r < M) slot[(size_t)r * 16 + 4 * u.pn + wc] = ss; }
        }
    }
};
struct EpiFinalB {
    static constexpr bool PERM = true, AFTER_DRAIN = false;
    const bf16_t* X; float* out;
    __device__ __forceinline__ void operator()(const f32x4 (&acc)[2][2][4][2], const Unit& u, int wr, int wc, int fr, int fq) const {
        const int row0 = u.pm * BM + wr * 64 + fr, col0 = u.pn * BM + wc * 32 + 8 * fq;
#pragma unroll
        for (int ai = 0; ai < 2; ++ai) {
            u32x4 o[4][2];
#pragma unroll
            for (int m = 0; m < 4; ++m)
#pragma unroll
                for (int bj = 0; bj < 2; ++bj) o[m][bj] = *(const u32x4*)(X + (size_t)(row0 + ai * HALF + m * 16) * D + col0 + bj * HALF);
#pragma unroll
            for (int m = 0; m < 4; ++m) { const int r = row0 + ai * HALF + m * 16; float* dst = nullptr;
                if (r < MP) { const int b = r / TP, t = r - b * TP; if (t >= NMETA) dst = out + O_YP + ((size_t)b * SEQ + (t - NMETA)) * D; }
                else if (r < M) dst = out + O_YS + (size_t)(r - MP) * D;
                if (dst) {
#pragma unroll
                    for (int bj = 0; bj < 2; ++bj) { const u32x4 q = o[m][bj]; const f32x4 v0 = acc[ai][bj][m][0], v1 = acc[ai][bj][m][1];
                        *(f32x4*)(dst + col0 + bj * HALF) = (f32x4){bflo(q.x) + v0[0], bfhi(q.x) + v0[1], bflo(q.y) + v0[2], bfhi(q.y) + v0[3]};
                        *(f32x4*)(dst + col0 + bj * HALF + 4) = (f32x4){bflo(q.z) + v1[0], bfhi(q.z) + v1[1], bflo(q.w) + v1[2], bfhi(q.w) + v1[3]}; } } }
        }
    }
};
struct EpiSwiglu {
    static constexpr bool PERM = true, AFTER_DRAIN = false;
    bf16_t* O; const float* rs;
    __device__ __forceinline__ void operator()(const f32x4 (&acc)[2][2][4][2], const Unit& u, int wr, int wc, int fr, int fq) const {
        const int row0 = u.pm * BM + wr * 64 + fr, col0 = u.pn * HALF + wc * 32 + 8 * fq;
        float sv[2][4];
#pragma unroll
        for (int ai = 0; ai < 2; ++ai)
#pragma unroll
            for (int m = 0; m < 4; ++m) sv[ai][m] = rs[row0 + ai * HALF + m * 16];
#pragma unroll
        for (int ai = 0; ai < 2; ++ai)
#pragma unroll
            for (int m = 0; m < 4; ++m) { const int row = row0 + ai * HALF + m * 16; const float s = sv[ai][m]; bf16_t* rowp = O + (size_t)row * DFF + col0;
                float r[8];
#pragma unroll
                for (int n = 0; n < 2; ++n)
#pragma unroll
                    for (int j = 0; j < 4; ++j) { const float g = acc[ai][0][m][n][j] * s, up = acc[ai][1][m][n][j] * s;
                        r[n * 4 + j] = g * up * __builtin_amdgcn_rcpf(1.0f + __builtin_amdgcn_exp2f(-1.4426950408889634f * g)); }
                u32x4 w; w.x = cvt_pk_bf16(r[0], r[1]); w.y = cvt_pk_bf16(r[2], r[3]); w.z = cvt_pk_bf16(r[4], r[5]); w.w = cvt_pk_bf16(r[6], r[7]);
                *(u32x4*)rowp = w; }
    }
};

template <class Epi, class Sched, bool ALIGN_EPI = false, bool SP2 = false>
__device__ __forceinline__ void gemm_phase(LAS unsigned char* lds, const Gemm g, const Sched& S, const Epi& E) {
    int tid = threadIdx.x; asm volatile("" : "+v"(tid));
    const int wid = __builtin_amdgcn_readfirstlane(tid >> 6), lane = tid & 63, wr = wid >> 2, wc = wid & 3, fr = lane & 15, fq = lane >> 4;
    const int K = g.K, nt = K / BK;
    unsigned voffA[2], voffB[2];
#pragma unroll
    for (int i = 0; i < 2; ++i) { int R, C; stage_rc(tid * 16 + i * 8192, R, C); const int Rb = Epi::PERM ? ((R & ~31) + perm32(R & 31)) : R;
        voffA[i] = (unsigned)(R * K + C) * 2u; voffB[i] = (unsigned)(Rb * K + C) * 2u; }
    const size_t kstep = (size_t)(BK * 2);
    const size_t hstep = (size_t)HALF * K * 2;
    const size_t tstep = 2 * hstep;
    const unsigned ldsw = (unsigned)wid * 1024u;
    const int aoff = lds_byte(wr * 64 + fr, fq * 8), boff = lds_byte(wc * 32 + fr, fq * 8);
#define PG8_SA(b, h) (((b) * 2 + (h)) * HTB)
#define PG8_SB(b, h) ((4 + (b) * 2 + (h)) * HTB)
#define PG8_STAGE(bufoff, gbase, voff) do { _Pragma("unroll") for (int _i = 0; _i < 2; ++_i) \
        __builtin_amdgcn_global_load_lds((const unsigned*)((const char*)(gbase) + (voff)[_i]), (LAS unsigned*)(lds + (bufoff) + ldsw + _i * 8192), 16, 0, 0); } while (0)
#define PG8_LDA(dst, b, h) do { _Pragma("unroll") for (int m = 0; m < 4; ++m) _Pragma("unroll") for (int k = 0; k < 2; ++k) dst[m][k] = *(const LAS bf16x8*)(lds + PG8_SA(b, h) + aoff + m * 2048 + k * 1024); } while (0)
#define PG8_LDB(dst, b, h) do { _Pragma("unroll") for (int n = 0; n < 2; ++n) _Pragma("unroll") for (int k = 0; k < 2; ++k) dst[n][k] = *(const LAS bf16x8*)(lds + PG8_SB(b, h) + boff + n * 2048 + k * 1024); } while (0)
#define PG8_MMA(ai, bj, At, Bt) do { __builtin_amdgcn_s_setprio(1); _Pragma("unroll") for (int m = 0; m < 4; ++m) _Pragma("unroll") for (int n = 0; n < 2; ++n) _Pragma("unroll") for (int k = 0; k < 2; ++k) \
        acc[ai][bj][m][n] = __builtin_amdgcn_mfma_f32_16x16x32_bf16(Bt[n][k], At[m][k], acc[ai][bj][m][n], 0, 0, 0); __builtin_amdgcn_s_setprio(0); } while (0)
#define PG8_WAIT_V(n) asm volatile("s_waitcnt vmcnt(" #n ")" ::: "memory")
#define PG8_WAIT_L(n) asm volatile("s_waitcnt lgkmcnt(" #n ")" ::: "memory")
#define PG8_BAR __builtin_amdgcn_s_barrier()
#define PG8_SCHED __builtin_amdgcn_sched_barrier(0)
    Unit cur, nxt; int ui = 0;
    if (!S.next(0, cur)) return;
    f32x4 acc[2][2][4][2];
#pragma unroll
    for (int a = 0; a < 2; ++a)
#pragma unroll
        for (int b = 0; b < 2; ++b)
#pragma unroll
            for (int m = 0; m < 4; ++m)
#pragma unroll
                for (int n = 0; n < 2; ++n) acc[a][b][m][n] = (f32x4){0.f, 0.f, 0.f, 0.f};
    bf16x8 At[4][2], B0[2][2], B1[2][2];
    const char* cA = (const char*)g.A + (size_t)cur.pm * tstep; const char* cB = (const char*)g.Bt + (size_t)cur.pn * tstep;
    S.a_ready(cur);
    if constexpr (SP2) {
        PG8_STAGE(PG8_SB(0, 0), cB, voffB); PG8_STAGE(PG8_SB(0, 1), cB + hstep, voffB); PG8_STAGE(PG8_SA(0, 0), cA, voffA); PG8_STAGE(PG8_SA(0, 1), cA + hstep, voffA);
        if (wr == 1) PG8_BAR;
        PG8_WAIT_V(2); PG8_BAR;
        PG8_STAGE(PG8_SB(1, 0), cB + kstep, voffB); PG8_STAGE(PG8_SA(1, 0), cA + kstep, voffA); PG8_STAGE(PG8_SB(1, 1), cB + hstep + kstep, voffB);
        PG8_WAIT_V(6); PG8_BAR;
    } else {
        PG8_STAGE(PG8_SB(0, 0), cB, voffB); PG8_STAGE(PG8_SA(0, 0), cA, voffA); PG8_STAGE(PG8_SB(0, 1), cB + hstep, voffB); PG8_STAGE(PG8_SA(0, 1), cA + hstep, voffA);
        if (wr == 1) PG8_BAR;
        PG8_WAIT_V(4); PG8_BAR;
        PG8_STAGE(PG8_SB(1, 0), cB + kstep, voffB); PG8_STAGE(PG8_SA(1, 0), cA + kstep, voffA); PG8_STAGE(PG8_SB(1, 1), cB + hstep + kstep, voffB);
        PG8_WAIT_V(6); PG8_BAR;
    }
    for (;;) {
        const bool has_next = S.next(ui + 1, nxt);
        const char* nA = has_next ? (const char*)g.A + (size_t)nxt.pm * tstep : cA; const char* nB = has_next ? (const char*)g.Bt + (size_t)nxt.pn * tstep : cB;
#pragma nounroll
        for (int t = 0; t < nt; t += 2) {
            const bool last = (t == nt - 2);
            const char* a1 = cA + (size_t)(t + 1) * kstep;
            const char* a2 = last ? nA : cA + (size_t)(t + 2) * kstep; const char* b2 = last ? nB : cB + (size_t)(t + 2) * kstep;
            const char* a3 = a2 + kstep; const char* b3 = b2 + kstep;
            if (last && has_next) S.a_ready(nxt);
            if constexpr (SP2) {
            PG8_LDB(B0, 0, 0); PG8_LDB(B1, 0, 1); PG8_SCHED; PG8_LDA(At, 0, 0); PG8_STAGE(PG8_SA(1, 1), a1 + hstep, voffA);
            PG8_WAIT_V(8); PG8_WAIT_L(0); PG8_BAR; PG8_MMA(0, 0, At, B0); PG8_MMA(0, 1, At, B1); PG8_BAR; PG8_SCHED;
            PG8_LDA(At, 0, 1); PG8_STAGE(PG8_SB(0, 0), b2, voffB); PG8_STAGE(PG8_SB(0, 1), b2 + hstep, voffB); PG8_STAGE(PG8_SA(0, 0), a2, voffA);
            PG8_WAIT_V(8); PG8_WAIT_L(0); PG8_BAR; PG8_MMA(1, 0, At, B0); PG8_MMA(1, 1, At, B1); PG8_BAR; PG8_SCHED;
            PG8_LDB(B0, 1, 0); PG8_LDB(B1, 1, 1); PG8_SCHED; PG8_LDA(At, 1, 0); PG8_STAGE(PG8_SA(0, 1), a2 + hstep, voffA);
            PG8_WAIT_V(8); PG8_WAIT_L(0); PG8_BAR; PG8_MMA(0, 0, At, B0); PG8_MMA(0, 1, At, B1); PG8_BAR; PG8_SCHED;
            PG8_LDA(At, 1, 1); PG8_STAGE(PG8_SB(1, 0), b3, voffB); PG8_STAGE(PG8_SB(1, 1), b3 + hstep, voffB); PG8_STAGE(PG8_SA(1, 0), a3, voffA);
            PG8_WAIT_V(8); PG8_WAIT_L(0); PG8_BAR; PG8_MMA(1, 0, At, B0); PG8_MMA(1, 1, At, B1); PG8_BAR; PG8_SCHED;
            } else {
            PG8_LDB(B0, 0, 0); PG8_SCHED; PG8_LDA(At, 0, 0); PG8_STAGE(PG8_SA(1, 1), a1 + hstep, voffA);
            PG8_WAIT_L(8); PG8_BAR; PG8_WAIT_L(0); PG8_MMA(0, 0, At, B0); PG8_BAR; PG8_SCHED;
            PG8_LDB(B1, 0, 1); PG8_STAGE(PG8_SB(0, 0), b2, voffB);
            PG8_BAR; PG8_WAIT_L(0); PG8_MMA(0, 1, At, B1); PG8_BAR;
            PG8_LDA(At, 0, 1); PG8_STAGE(PG8_SA(0, 0), a2, voffA);
            PG8_BAR; PG8_WAIT_L(0); PG8_MMA(1, 0, At, B0); PG8_BAR; PG8_SCHED;
            PG8_STAGE(PG8_SB(0, 1), b2 + hstep, voffB);
            PG8_WAIT_V(6); PG8_BAR; PG8_MMA(1, 1, At, B1); PG8_BAR;
            PG8_LDB(B0, 1, 0); PG8_SCHED; PG8_LDA(At, 1, 0); PG8_STAGE(PG8_SA(0, 1), a2 + hstep, voffA);
            PG8_WAIT_L(8); PG8_BAR; PG8_WAIT_L(0); PG8_MMA(0, 0, At, B0); PG8_BAR; PG8_SCHED;
            PG8_LDB(B1, 1, 1); PG8_STAGE(PG8_SB(1, 0), b3, voffB);
            PG8_BAR; PG8_WAIT_L(0); PG8_MMA(0, 1, At, B1); PG8_BAR;
            PG8_LDA(At, 1, 1); PG8_STAGE(PG8_SA(1, 0), a3, voffA);
            PG8_BAR; PG8_WAIT_L(0); PG8_MMA(1, 0, At, B0); PG8_BAR; PG8_SCHED;
            PG8_STAGE(PG8_SB(1, 1), b3 + hstep, voffB);
            PG8_WAIT_V(6); PG8_BAR; PG8_MMA(1, 1, At, B1); PG8_BAR;
            }
        }
        if constexpr (ALIGN_EPI) { if (wr == 0) PG8_BAR; }
        E(acc, cur, wr, wc, fr, fq); S.done(cur);
        if (!has_next) break;
#pragma unroll
        for (int a = 0; a < 2; ++a)
#pragma unroll
            for (int b = 0; b < 2; ++b)
#pragma unroll
                for (int m = 0; m < 4; ++m)
#pragma unroll
                    for (int n = 0; n < 2; ++n) acc[a][b][m][n] = (f32x4){0.f, 0.f, 0.f, 0.f};
        cur = nxt; cA = nA; cB = nB; ++ui;
        if constexpr (ALIGN_EPI) { if (wr == 1) PG8_BAR; }
    }
    PG8_WAIT_V(0);
    if constexpr (!ALIGN_EPI) { if (wr == 0) PG8_BAR; }
    PG8_BAR;
#undef PG8_SA
#undef PG8_SB
#undef PG8_STAGE
#undef PG8_LDA
#undef PG8_LDB
#undef PG8_MMA
#undef PG8_WAIT_V
#undef PG8_WAIT_L
#undef PG8_BAR
#undef PG8_SCHED
}
}

template <class Epi>
__device__ __forceinline__ void run_gemm(LAS unsigned char* lds, const bf16_t* A, const bf16_t* Bt, int Mm, int Nn, int Kk, const Epi& E, int rot) {
    pg8::Gemm g{A, Bt, Mm, Nn, Kk};
    pg8::StaticOrder S; S.init(Mm, Nn, (int)gridDim.x, (int)((blockIdx.x + rot) % gridDim.x));
    pg8::gemm_phase<Epi, pg8::StaticOrder, true, true>(lds, g, S, E);
}

__device__ __forceinline__ int opaque_tid() { int t = threadIdx.x; asm volatile("" : "+v"(t)); return t; }
struct XJob { const float* W; const float* W2; int ldw; int k0; int Ksz; int Nd; int nvalid; int mode; bf16_t* dst; int ldd; int kc0; const float* kscale; };
__device__ __forceinline__ void xpose_load(const XJob& J, int tile, int tid, float (&v)[8]) {
    const int ktiles = J.Ksz / 64, nt = tile / ktiles, kt = tile % ktiles, n0 = nt * 64, kk0 = kt * 64;
    const float* src = J.W; int scol0 = n0;
    if (J.mode == 1) { const int pn = n0 / 256, rem = n0 % 256; src = (rem >= 128) ? J.W2 : J.W; scol0 = 128 * pn + (rem & 127); }
    const int nl = tid & 63, kq = tid >> 6;
    const bool ok = (n0 + nl) < J.nvalid;
    int scol = scol0 + nl;
    if (J.mode == 2) { const int n = n0 + nl, pn = n >> 8, cp = n & 255, bj = cp >> 7, wc = (cp & 127) >> 5, jj = cp & 31; scol = (4 * pn + wc) * 64 + 32 * bj + jj; }
    if (!ok) scol = scol0;
#pragma unroll
    for (int i = 0; i < 8; ++i) { const int kl = kq + 8 * i; const float ksc = J.kscale ? J.kscale[J.k0 + kk0 + kl] : 1.f; const float w = src[(size_t)(J.k0 + kk0 + kl) * J.ldw + scol]; v[i] = ok ? w * ksc : 0.f; }
}
__device__ __forceinline__ void xpose_store(const XJob& J, int tile, int tid, const float (&v)[8], LAS float* scr, int next_tile, float (&vn)[8]) {
    const int ktiles = J.Ksz / 64, nt = tile / ktiles, kt = tile % ktiles, n0 = nt * 64, kk0 = kt * 64;
    { const int nl = tid & 63, kq = tid >> 6;
#pragma unroll
      for (int i = 0; i < 8; ++i) scr[(kq + 8 * i) * 65 + nl] = v[i]; }
    __syncthreads();
    if (next_tile >= 0) xpose_load(J, next_tile, tid, vn);
    {
        const int k8 = tid & 7, nl = tid >> 3;
        const LAS float* s = scr + (8 * k8) * 65 + nl;
        u32x4 o; o.x = pk2(s[0], s[65]); o.y = pk2(s[2 * 65], s[3 * 65]); o.z = pk2(s[4 * 65], s[5 * 65]); o.w = pk2(s[6 * 65], s[7 * 65]);
        *(u32x4*)(J.dst + (size_t)(n0 + nl) * J.ldd + J.kc0 + kk0 + 8 * k8) = o;
    }
    __syncthreads();
}
__device__ __forceinline__ void phase_prep(const Params& p, LAS unsigned char* lds, int l, int jmask, int vb, int vg) {
    LAS float* scr = (LAS float*)lds;
    bf16_t* wts = (bf16_t*)(p.ws + WS_WTS);
    {
        bf16_t* wl = wts + (size_t)l * W_LAYER;
        for (int j = 0; j < 7; ++j) {
            if (!((jmask >> j) & 1)) continue;
            XJob J;
            switch (j) {
                case 0: J = XJob{p.w_in + (size_t)l * D * DIN, nullptr, DIN, 0, D, DINP, DIN, 0, wl + W_IN, D, 0, p.norm_mix + (size_t)l * D}; break;
                case 1: J = XJob{p.w_uq + (size_t)l * QRK * 768, nullptr, 768, 0, QRK, 768, 768, 0, wl + W_UQ, QRK, 0, nullptr}; break;
                case 2: J = XJob{p.w_uk + (size_t)l * KVR * 512, nullptr, 512, 0, KVR, 512, 512, 2, wl + W_UK, KVR, 0, nullptr}; break;
                case 3: J = XJob{p.w_uv + (size_t)l * KVR * 512, nullptr, 512, 0, KVR, 512, 512, 0, wl + W_UV, KVR, 0, nullptr}; break;
                case 4: J = XJob{p.w_o + (size_t)l * D * D, nullptr, D, 512, 512, D, D, 0, wl + W_O, D, 512, nullptr}; break;
                case 5: J = XJob{p.w_gate + (size_t)l * D * DFF, p.w_up + (size_t)l * D * DFF, DFF, 0, D, 2 * DFF, 2 * DFF, 1, wl + W_GU, D, 0, p.norm_ffn + (size_t)l * D}; break;
                default: J = XJob{p.w_down + (size_t)l * DFF * D, nullptr, D, 0, DFF, D, D, 0, wl + W_DN, DFF, 0, nullptr}; break;
            }
            const int ntiles = (J.Nd / 64) * (J.Ksz / 64);
            {
                const int tid = opaque_tid(), G = vg;
                float v[8], vn[8];
                int t = vb;
                if (t < ntiles) xpose_load(J, t, tid, v);
                for (; t < ntiles; t += G) {
                    const int tn = (t + G < ntiles) ? t + G : -1;
                    xpose_store(J, t, tid, v, scr, tn, vn);
#pragma unroll
                    for (int i = 0; i < 8; ++i) v[i] = vn[i];
                }
            }
        }
        const float* wp = p.w_pool + (size_t)l * 4 * 128 * 128; const float* ps = p.pool_scale + (size_t)l * PW; const float* wo = p.w_o + (size_t)l * D * D;
        if ((jmask >> 7) & 1)
        for (int idx = vb * 512 + opaque_tid(); idx < 64 * 1024; idx += vg * 512) {
            const int k8 = idx >> 10, n = idx & 1023, k0 = k8 * 8, g = k0 >> 7, kk0 = k0 & 127;
            const float* wpr = wp + ((size_t)g * 128 + kk0) * 128;
            float s[8] = {0.f, 0.f, 0.f, 0.f, 0.f, 0.f, 0.f, 0.f};
#pragma nounroll
            for (int j0 = 0; j0 < 128; j0 += 16) {
                float t[16];
#pragma unroll
                for (int jj = 0; jj < 16; ++jj) t[jj] = ps[g * 128 + j0 + jj] * wo[(size_t)(g * 128 + j0 + jj) * D + n];
#pragma unroll
                for (int e = 0; e < 8; ++e) { const f32x4* wq = (const f32x4*)(wpr + e * 128 + j0); const f32x4 a = wq[0], b = wq[1], c = wq[2], d = wq[3];
                    s[e] += ((a.x * t[0] + a.y * t[1]) + (a.z * t[2] + a.w * t[3])) + ((b.x * t[4] + b.y * t[5]) + (b.z * t[6] + b.w * t[7]))
                          + ((c.x * t[8] + c.y * t[9]) + (c.z * t[10] + c.w * t[11])) + ((d.x * t[12] + d.y * t[13]) + (d.z * t[14] + d.w * t[15])); }
            }
            u32x4 w; w.x = pk2(s[0], s[1]); w.y = pk2(s[2], s[3]); w.z = pk2(s[4], s[5]); w.w = pk2(s[6], s[7]);
            *(u32x4*)(wl + W_O + (size_t)n * D + k0) = w;
        }
    }
}

__device__ __forceinline__ void phase_rmsnorm_first(const Params& p) {
    const int tid_ = opaque_tid(), lane = tid_ & 63, gw = blockIdx.x * 8 + (tid_ >> 6), NW = gridDim.x * 8;
    bf16_t* xrb = (bf16_t*)(p.ws + WS_XRES); float* rs = (float*)(p.ws + WS_RS);
    constexpr int U = 4;
    for (int r0 = gw; r0 < M; r0 += NW * U) {
        f32x4 v[U][4]; float ss[U];
#pragma unroll
        for (int u = 0; u < U; ++u) {
            int r = r0 + u * NW; if (r >= M) r = r0;
            const float* src;
            if (r < MP) { const int b = r / TP, t = r - b * TP; src = (t < NMETA) ? p.meta + (size_t)t * D : p.x_prompt + ((size_t)b * SEQ + (t - NMETA)) * D; }
            else src = p.x_sample + (size_t)(r - MP) * D;
#pragma unroll
            for (int j = 0; j < 4; ++j) v[u][j] = *(const f32x4*)(src + 4 * lane + 256 * j);
        }
        u32x2 w[U][4];
#pragma unroll
        for (int u = 0; u < U; ++u) { float s = 0.f;
#pragma unroll
            for (int j = 0; j < 4; ++j) { w[u][j].x = pk2(v[u][j].x, v[u][j].y); w[u][j].y = pk2(v[u][j].z, v[u][j].w);
                s += (bflo(w[u][j].x) * bflo(w[u][j].x) + bfhi(w[u][j].x) * bfhi(w[u][j].x)) + (bflo(w[u][j].y) * bflo(w[u][j].y) + bfhi(w[u][j].y) * bfhi(w[u][j].y)); }
            ss[u] = s; }
#pragma unroll
        for (int u = 0; u < U; ++u) ss[u] = wave_sum(ss[u], lane);
#pragma unroll
        for (int u = 0; u < U; ++u) {
            const int r = r0 + u * NW;
            if (r < M) {
#pragma unroll
                for (int j = 0; j < 4; ++j) *(u32x2*)(xrb + (size_t)r * D + 4 * lane + 256 * j) = w[u][j];
                if (lane == 0) rs[r] = rsqrtf(ss[u] * (1.f / D) + EPS);
            }
        }
    }
    for (int r = M + blockIdx.x * 512 + opaque_tid(); r < MPAD; r += gridDim.x * 512) rs[r] = 0.f;
}
__device__ __forceinline__ void phase_rowstat(const Params& p) {
    const float* slot = (const float*)(p.ws + WS_SLOT); float* rs = (float*)(p.ws + WS_RS);
    for (int r = blockIdx.x * 512 + opaque_tid(); r < MPAD; r += gridDim.x * 512) {
        float o = 0.f;
        if (r < M) { const f32x4* sp = (const f32x4*)(slot + (size_t)r * 16); const f32x4 a = sp[0], b = sp[1], c = sp[2], d = sp[3];
            const float s = ((a.x + a.y) + (a.z + a.w)) + ((b.x + b.y) + (b.z + b.w)) + ((c.x + c.y) + (c.z + c.w)) + ((d.x + d.y) + (d.z + d.w));
            o = rsqrtf(s * (1.f / D) + EPS); }
        rs[r] = o;
    }
}

__device__ __forceinline__ void phase_cacheconv(const Params& p, int l, int vb, int vg) {
    bf16_t* lat = (bf16_t*)(p.ws + WS_HBUF);

        const f32x4* cl = (const f32x4*)(p.cache_latent + (size_t)l * DB * CROWS * KVR);
        constexpr int n4 = DB * CROWS * (KVR / 4);
        const int T = vg * 512;
        for (int i0 = vb * 512 + opaque_tid(); i0 < n4; i0 += T * 8) {
            f32x4 v[8];
#pragma unroll
            for (int u = 0; u < 8; ++u) { int i = i0 + u * T; if (i >= n4) i = i0; v[u] = cl[i]; }
#pragma unroll
            for (int u = 0; u < 8; ++u) { const int i = i0 + u * T;
                if (i < n4) { const int row = i >> 6, b = row / CROWS, j = row - b * CROWS;
                    u32x2 w; w.x = pk2(v[u].x, v[u].y); w.y = pk2(v[u].z, v[u].w);
                    *(u32x2*)(lat + ((size_t)MP + (size_t)b * SKP + j) * KVR + (i & 63) * 4) = w; } }
        }
        {
            float* ssk = (float*)(p.ws + WS_SSK);
            const float* ck = p.cache_krope + (size_t)l * DB * CROWS * DROPE;
            for (int i = vb * 512 + opaque_tid(); i < DB * SKP; i += vg * 512) {
                const int b = i / SKP, j = i - b * SKP;
                if (j < CROWS) { const f32x4* rp = (const f32x4*)(ck + ((size_t)b * CROWS + j) * DROPE); float s = 0.f;
#pragma unroll
                    for (int e = 0; e < 8; ++e) { const f32x4 v = rp[e]; s += (v.x * v.x + v.y * v.y) + (v.z * v.z + v.w * v.w); }
                    ssk[MP + i] = s; }
                else if (j >= SK) ssk[MP + i] = 0.f;
            }
        }
        const int npad = DB * (SKP - SK) * KVR / 4;
        for (int i = vb * 512 + opaque_tid(); i < npad; i += vg * 512) {
            const int e = i * 4, b = e / ((SKP - SK) * KVR), rem = e % ((SKP - SK) * KVR);
            u32x2 w; w.x = 0u; w.y = 0u;
            *(u32x2*)(lat + ((size_t)MP + (size_t)b * SKP + SK) * KVR + rem) = w;
        }
    }
__device__ __forceinline__ void phase_postin(const Params& p, int l) {
    const int tid_ = opaque_tid(), lane = tid_ & 63, gw = blockIdx.x * 8 + (tid_ >> 6), NW = gridDim.x * 8;
    const bf16_t* z = (const bf16_t*)(p.ws + WS_ACT);
    bf16_t* lat = (bf16_t*)(p.ws + WS_HBUF);
    bf16_t* mix = (bf16_t*)(p.ws + WS_MIX);
    bf16_t* qa = (bf16_t*)((unsigned char*)p.out + (size_t)KRPAD * 512 * 2);
    const float* qg = p.q_a_norm + (size_t)l * QRK; const float* kg = p.kv_a_norm + (size_t)l * KVR;
    f32x2 qgv[3];
#pragma unroll
    for (int j = 0; j < 3; ++j) qgv[j] = *(const f32x2*)(qg + 2 * lane + 128 * j);
    const f32x4 kgv = *(const f32x4*)(kg + 4 * lane);
    const double invf = INVF[lane & 15];
    constexpr int U = 3;
    for (int r0 = gw; r0 < M; r0 += NW * U) {
        f32x2 qv[U][3]; f32x4 kvv[U], uA[U], uB[U], sA[U], sB[U]; float x1[U], x2[U];
#pragma unroll
        for (int u = 0; u < U; ++u) {
            int r = r0 + u * NW; if (r >= M) r = r0;
            const bf16_t* zr = z + (size_t)r * DINP;
            const bool prompt = r < MP;
            int b, t;
            if (prompt) { b = r / TP; t = r - b * TP; } else { b = (r - MP) / DS; t = (r - MP) - b * DS; }
#pragma unroll
            for (int j = 0; j < 3; ++j) qv[u][j] = ld2(zr + PW + 2 * lane + 128 * j);
            kvv[u] = ld4(zr + PW + QRK + 4 * lane);
            x1[u] = bflo((unsigned)zr[PW + QRK + KVR + (lane & 15)]); x2[u] = bflo((unsigned)zr[PW + QRK + KVR + 16 + (lane & 15)]);
            uA[u] = ld4(zr + 4 * lane); uB[u] = ld4(zr + 256 + 4 * lane);
            const int g0 = lane >> 5;
            const int wA = 2 << g0, wB = 8 << g0;
            const int text = prompt ? t : 15 + t;
            const int cA = (text + 1 < wA) ? text + 1 : wA, cB = (text + 1 < wB) ? text + 1 : wB;
            f32x4 a = uA[u], bb = uB[u];
            if (prompt) {
                u32x2 wa[3], wb[15];
#pragma unroll
                for (int j = 1; j < 16; ++j) { const int jj = (j < t) ? j : t; const bf16_t* src = zr - (size_t)jj * DINP;
                    wb[j - 1] = *(const u32x2*)(src + 256 + 4 * lane); if (j < 4) wa[j - 1] = *(const u32x2*)(src + 4 * lane); }
#pragma unroll
                for (int j = 1; j < 16; ++j) {
                    const float mb = (j < cB) ? 1.f : 0.f;
                    bb = bb + (f32x4){bflo(wb[j - 1].x), bfhi(wb[j - 1].x), bflo(wb[j - 1].y), bfhi(wb[j - 1].y)} * mb;
                    if (j < 4) { const float ma = (j < cA) ? 1.f : 0.f; a = a + (f32x4){bflo(wa[j - 1].x), bfhi(wa[j - 1].x), bflo(wa[j - 1].y), bfhi(wa[j - 1].y)} * ma; }
                }
            } else {
                const float* hist = p.state_pool + ((size_t)l * DB + b) * 15 * PW;
                u32x2 za[3], zb[15]; f32x4 ha[3], hb[15];
#pragma unroll
                for (int j = 1; j < 16; ++j) { const int tz = (t >= j) ? t - j : 0, th = (t >= j) ? 0 : 15 + t - j;
                    const bf16_t* zs = z + ((size_t)MP + (size_t)b * DS + tz) * DINP; const float* hs = hist + (size_t)th * PW;
                    zb[j - 1] = *(const u32x2*)(zs + 256 + 4 * lane); hb[j - 1] = *(const f32x4*)(hs + 256 + 4 * lane);
                    if (j < 4) { za[j - 1] = *(const u32x2*)(zs + 4 * lane); ha[j - 1] = *(const f32x4*)(hs + 4 * lane); } }
#pragma unroll
                for (int j = 1; j < 16; ++j) {
                    const bool newrow = t >= j; const float mb = (j < cB) ? 1.f : 0.f;
                    const f32x4 zv = {bflo(zb[j - 1].x), bfhi(zb[j - 1].x), bflo(zb[j - 1].y), bfhi(zb[j - 1].y)};
                    bb = bb + (newrow ? zv : hb[j - 1]) * mb;
                    if (j < 4) { const float ma = (j < cA) ? 1.f : 0.f; const f32x4 zw = {bflo(za[j - 1].x), bfhi(za[j - 1].x), bflo(za[j - 1].y), bfhi(za[j - 1].y)};
                        a = a + (newrow ? zw : ha[j - 1]) * ma; }
                }
            }
            sA[u] = a * (1.f / (float)cA) - uA[u]; sB[u] = bb * (1.f / (float)cB) - uB[u];
        }
        float ssq[U], ssk[U];
#pragma unroll
        for (int u = 0; u < U; ++u) { ssq[u] = 0.f;
#pragma unroll
            for (int j = 0; j < 3; ++j) ssq[u] += qv[u][j].x * qv[u][j].x + qv[u][j].y * qv[u][j].y;
            ssk[u] = (kvv[u].x * kvv[u].x + kvv[u].y * kvv[u].y) + (kvv[u].z * kvv[u].z + kvv[u].w * kvv[u].w); }
#pragma unroll
        for (int u = 0; u < U; ++u) { ssq[u] = wave_sum(ssq[u], lane); ssk[u] = wave_sum(ssk[u], lane); }
#pragma unroll
        for (int u = 0; u < U; ++u) {
            const int r = r0 + u * NW;
            if (r < M) {
                const bool prompt = r < MP;
                int b, t;
                if (prompt) { b = r / TP; t = r - b * TP; } else { b = (r - MP) / DS; t = (r - MP) - b * DS; }
                const int pos = prompt ? t : CROWS + t;
                {
                    const float rs = rsqrtf(ssq[u] * (1.f / QRK) + EPS);
#pragma unroll
                    for (int j = 0; j < 3; ++j) { const f32x2 g = qgv[j]; *(unsigned*)(qa + (size_t)r * QRK + 2 * lane + 128 * j) = pk2(qv[u][j].x * rs * g.x, qv[u][j].y * rs * g.y); }
                }
                {
                    const float rs = rsqrtf(ssk[u] * (1.f / KVR) + EPS);
                    const f32x4 o = kvv[u] * rs * kgv;
                    float* dst = prompt ? p.out + O_LATP + ((size_t)l * MP + r) * KVR : p.out + O_LATS + ((size_t)l * MS + (r - MP)) * KVR;
                    *(f32x4*)(dst + 4 * lane) = o;
                    const size_t krow = prompt ? (size_t)r : (size_t)MP + (size_t)b * SKP + CROWS + t;
                    u32x2 w; w.x = pk2(o.x, o.y); w.y = pk2(o.z, o.w);
                    *(u32x2*)(lat + krow * KVR + 4 * lane) = w;
                }
                {
                    float sq = x1[u] * x1[u] + x2[u] * x2[u];
                    sq += shx<1>(sq); sq += shx<2>(sq); sq += shx<4>(sq); sq += shx<8>(sq);
                    if (lane < 16) {
                        float c, s; { const double rev = (double)pos * invf * 0.15915494309189535; const float fr = (float)(rev - floor(rev)); c = __builtin_amdgcn_cosf(fr); s = __builtin_amdgcn_sinf(fr); }
                        float* dst = prompt ? p.out + O_KPEP + ((size_t)l * MP + r) * DROPE : p.out + O_KPES + ((size_t)l * MS + (r - MP)) * DROPE;
                        dst[lane] = x1[u] * c - x2[u] * s; dst[16 + lane] = x1[u] * s + x2[u] * c;
                        if (lane == 0) { const size_t krow = prompt ? (size_t)r : (size_t)MP + (size_t)b * SKP + CROWS + t; ((float*)(p.ws + WS_SSK))[krow] = sq; }
                    }
                }
                {
                    u32x2 w; w.x = pk2(sA[u].x, sA[u].y); w.y = pk2(sA[u].z, sA[u].w); *(u32x2*)(mix + (size_t)r * D + 4 * lane) = w;
                    w.x = pk2(sB[u].x, sB[u].y); w.y = pk2(sB[u].z, sB[u].w); *(u32x2*)(mix + (size_t)r * D + 256 + 4 * lane) = w;
                    const int tail = prompt ? t - (TP - 15) : t - (DS - 15);
                    if (tail >= 0) {
                        float* dst = prompt ? p.out + O_POOLP + (((size_t)l * NB + b) * 15 + tail) * PW : p.out + O_POOLS + (((size_t)l * DB + b) * 15 + tail) * PW;
                        *(f32x4*)(dst + 4 * lane) = uA[u]; *(f32x4*)(dst + 256 + 4 * lane) = uB[u];
                    }
                }
            }
        }
    }
}

__device__ __forceinline__ const float* kpe_row(const Params& p, int l, int kr) {
    if (kr < MP) return p.out + O_KPEP + ((size_t)l * MP + kr) * DROPE;
    const int b = (kr - MP) / SKP, j = (kr - MP) - b * SKP;
    if (j < CROWS) return p.cache_krope + (((size_t)l * DB + b) * CROWS + j) * DROPE;
    if (j < SK) return p.out + O_KPES + ((size_t)l * MS + b * DS + (j - CROWS)) * DROPE;
    return nullptr;
}
struct EpiKnorm {
    static constexpr bool PERM = true, AFTER_DRAIN = false;
    Params p; int l;
    __device__ __forceinline__ void operator()(const f32x4 (&acc)[2][2][4][2], const pg8::Unit& u, int wr, int wc, int fr, int fq) const {
        bf16_t* Kn = (bf16_t*)(p.ws + WS_ACT); bf16_t* Kr = Kn + (size_t)KRPAD * 512;
        const float* ssk = (const float*)(p.ws + WS_SSK);
        const float* kn = p.k_norm + (size_t)l * DQK;
        const int h = 4 * u.pn + wc, lane = fq * 16 + fr;
        const int row0 = u.pm * 256 + wr * 64 + fr;
        f32x4 gn[2][2], gr[2];
#pragma unroll
        for (int bj = 0; bj < 2; ++bj) { gn[bj][0] = *(const f32x4*)(kn + 32 * bj + 8 * fq); gn[bj][1] = *(const f32x4*)(kn + 32 * bj + 8 * fq + 4); }
        gr[0] = *(const f32x4*)(kn + 64 + 8 * fq); gr[1] = *(const f32x4*)(kn + 64 + 8 * fq + 4);
#pragma unroll
        for (int ai = 0; ai < 2; ++ai) {
            float sk[4]; f32x4 pa[4], pc[4];
#pragma unroll
            for (int m = 0; m < 4; ++m) { const int row = row0 + ai * 128 + m * 16, rc = (row < KR) ? row : 0;
                sk[m] = ssk[rc];
                const float* kpe = kpe_row(p, l, rc); const bool has = kpe != nullptr; const float* kq = has ? kpe : kn;
                pa[m] = *(const f32x4*)(kq + 8 * fq); pc[m] = *(const f32x4*)(kq + 8 * fq + 4);
                const float mk = has ? 1.f : 0.f; pa[m] = pa[m] * mk; pc[m] = pc[m] * mk; }
#pragma unroll
            for (int m = 0; m < 4; ++m) {
                const int row = row0 + ai * 128 + m * 16;
                float ss = 0.f;
#pragma unroll
                for (int bj = 0; bj < 2; ++bj)
#pragma unroll
                    for (int n = 0; n < 2; ++n) { const f32x4 v = acc[ai][bj][m][n]; ss += (v[0] * v[0] + v[1] * v[1]) + (v[2] * v[2] + v[3] * v[3]); }
                ss += shx<16>(ss); ss += shx32(ss, lane);
                if (row < KR) {
                    const float rs = rsqrtf((ss + sk[m]) * (1.f / DQK) + EPS);
#pragma unroll
                    for (int bj = 0; bj < 2; ++bj) {
                        const f32x4 v0 = acc[ai][bj][m][0] * rs * gn[bj][0], v1 = acc[ai][bj][m][1] * rs * gn[bj][1];
                        u32x4 w; w.x = pk2(v0[0], v0[1]); w.y = pk2(v0[2], v0[3]); w.z = pk2(v1[0], v1[1]); w.w = pk2(v1[2], v1[3]);
                        *(u32x4*)(Kn + (size_t)row * 512 + h * 64 + 32 * bj + 8 * fq) = w;
                    }
                    const f32x4 a = pa[m] * rs * gr[0], c = pc[m] * rs * gr[1];
                    u32x4 w; w.x = pk2(a[0], a[1]); w.y = pk2(a[2], a[3]); w.z = pk2(c[0], c[1]); w.w = pk2(c[2], c[3]);
                    *(u32x4*)(Kr + (size_t)row * 256 + h * 32 + 8 * fq) = w;
                }
            }
        }
    }
};
__device__ __forceinline__ void phase_knorm(const Params& p, int l) {
    const int tid_ = opaque_tid(), lane = tid_ & 63, gw = blockIdx.x * 8 + (tid_ >> 6), NW = gridDim.x * 8;
    bf16_t* Kn = (bf16_t*)(p.ws + WS_ACT); bf16_t* Kr = Kn + (size_t)KRPAD * 512;
    const float* kn = p.k_norm + (size_t)l * DQK;
    const int c0 = (lane & 7) * 8;
    float gn[8];
#pragma unroll
    for (int j = 0; j < 8; ++j) gn[j] = kn[c0 + j];
    const f32x4 gr = *(const f32x4*)(kn + 64 + (lane & 7) * 4);
    constexpr int U = 4;
    for (int k0 = gw; k0 < KR; k0 += NW * U) {
        u32x4 raw[U]; float pe[U]; f32x4 pv[U];
#pragma unroll
        for (int u = 0; u < U; ++u) {
            int kr = k0 + u * NW; if (kr >= KR) kr = k0;
            const float* kpe = kpe_row(p, l, kr);
            pe[u] = kpe ? kpe[lane & 31] : 0.f;
            pv[u] = (f32x4){0.f, 0.f, 0.f, 0.f};
            if (kpe) pv[u] = *(const f32x4*)(kpe + (lane & 7) * 4);
            raw[u] = *(const u32x4*)(Kn + (size_t)kr * 512 + 8 * lane);
        }
        float sp[U], ss[U];
#pragma unroll
        for (int u = 0; u < U; ++u) { sp[u] = pe[u] * pe[u];
            const float v[8] = {bflo(raw[u].x), bfhi(raw[u].x), bflo(raw[u].y), bfhi(raw[u].y), bflo(raw[u].z), bfhi(raw[u].z), bflo(raw[u].w), bfhi(raw[u].w)};
            float s = 0.f;
#pragma unroll
            for (int j = 0; j < 8; ++j) s += v[j] * v[j];
            ss[u] = s; }
#pragma unroll
        for (int u = 0; u < U; ++u) { sp[u] = sum32(sp[u]); ss[u] += shx<1>(ss[u]); ss[u] += shx<2>(ss[u]); ss[u] += shx<4>(ss[u]); }
#pragma unroll
        for (int u = 0; u < U; ++u) {
            const int kr = k0 + u * NW;
            if (kr < KR) {
                const float v[8] = {bflo(raw[u].x), bfhi(raw[u].x), bflo(raw[u].y), bfhi(raw[u].y), bflo(raw[u].z), bfhi(raw[u].z), bflo(raw[u].w), bfhi(raw[u].w)};
                const float rs = rsqrtf((ss[u] + sp[u]) * (1.f / DQK) + EPS);
                u32x4 o; o.x = pk2(v[0] * rs * gn[0], v[1] * rs * gn[1]); o.y = pk2(v[2] * rs * gn[2], v[3] * rs * gn[3]);
                o.z = pk2(v[4] * rs * gn[4], v[5] * rs * gn[5]); o.w = pk2(v[6] * rs * gn[6], v[7] * rs * gn[7]);
                *(u32x4*)(Kn + (size_t)kr * 512 + 8 * lane) = o;
                const f32x4 q = pv[u] * rs * gr;
                u32x2 w; w.x = pk2(q.x, q.y); w.y = pk2(q.z, q.w);
                *(u32x2*)(Kr + (size_t)kr * 256 + 4 * lane) = w;
            }
        }
    }
}

constexpr int KROW = 208, VROW = 144, KT_BYTES = 64 * KROW, VT_BYTES = 64 * VROW, ATT_BUF = KT_BYTES + VT_BYTES;

__device__ __forceinline__ size_t vt_off(int dvrow, int kr) { return ((size_t)(kr >> 6) * 512 + dvrow) * 64 + (kr & 63); }
__device__ __forceinline__ void q_prologue(const Params& p, int l, int qrow, int pos, int h, int hf, int lane, bf16x8 (&qf)[6]) {
    const bf16_t* qraw = (const bf16_t*)(p.ws + WS_QRAW);
    const float* qn = p.q_norm + (size_t)l * DQK;
    const bf16_t* qp = qraw + (size_t)qrow * 768 + h * DQK + 8 * hf;
    float v[6][8];
#pragma unroll
    for (int s = 0; s < 6; ++s) { const u32x4 raw = *(const u32x4*)(qp + 16 * s);
        v[s][0] = bflo(raw.x); v[s][1] = bfhi(raw.x); v[s][2] = bflo(raw.y); v[s][3] = bfhi(raw.y); v[s][4] = bflo(raw.z); v[s][5] = bfhi(raw.z); v[s][6] = bflo(raw.w); v[s][7] = bfhi(raw.w); }
#pragma unroll
    for (int e = 0; e < 8; ++e) { float c, s; rope_cs(pos, 8 * hf + e, c, s); const float x1 = v[4][e], x2 = v[5][e]; v[4][e] = x1 * c - x2 * s; v[5][e] = x1 * s + x2 * c; }
    float ss = 0.f;
#pragma unroll
    for (int s = 0; s < 6; ++s)
#pragma unroll
        for (int e = 0; e < 8; ++e) ss += v[s][e] * v[s][e];
    ss += shx32(ss, lane);
    const float rs = rsqrtf(ss * (1.f / DQK) + EPS) * 0.14724444602590306f;
#pragma unroll
    for (int s = 0; s < 6; ++s) { const float* g = qn + 16 * s + 8 * hf; u32x4 w;
        w.x = pk2(v[s][0] * rs * g[0], v[s][1] * rs * g[1]); w.y = pk2(v[s][2] * rs * g[2], v[s][3] * rs * g[3]);
        w.z = pk2(v[s][4] * rs * g[4], v[s][5] * rs * g[5]); w.w = pk2(v[s][6] * rs * g[6], v[s][7] * rs * g[7]);
        qf[s] = __builtin_bit_cast(bf16x8, w); }
}
template <bool MASKED>
__device__ __forceinline__ void attn_step(const bf16x8 (&ka)[2][6], const bf16x8 (&va)[2][4], const bf16x8 (&qf)[6], int nvalid, int lane, f32x16& o0, f32x16& o1, float& mrun, float& lsum) {
    f32x16 s0, s1;
#pragma unroll
    for (int i = 0; i < 16; ++i) { s0[i] = 0.f; s1[i] = 0.f; }
#pragma unroll
    for (int s = 0; s < 6; ++s) { s0 = __builtin_amdgcn_mfma_f32_32x32x16_bf16(ka[0][s], qf[s], s0, 0, 0, 0); s1 = __builtin_amdgcn_mfma_f32_32x32x16_bf16(ka[1][s], qf[s], s1, 0, 0, 0); }
    if (MASKED) {
#pragma unroll
        for (int i = 0; i < 16; ++i) { if (16 * (i >> 3) >= nvalid) s0[i] = -INFINITY; if (32 + 16 * (i >> 3) >= nvalid) s1[i] = -INFINITY; }
    }
    float mx = fmaxf(fmaxf(s0[0], s0[1]), s0[2]);
#pragma unroll
    for (int i = 3; i < 15; i += 2) mx = fmaxf(fmaxf(mx, s0[i]), s0[i + 1]);
    mx = fmaxf(mx, s0[15]);
#pragma unroll
    for (int i = 0; i < 16; i += 2) mx = fmaxf(fmaxf(mx, s1[i]), s1[i + 1]);
    if (__builtin_amdgcn_ballot_w64(mx > mrun + 8.0f) != 0ull) {
        mx = fmaxf(mx, shx32(mx, lane));
        const float mnew = fmaxf(mrun, mx);
        const float alpha = __builtin_amdgcn_exp2f(mrun - mnew);
        mrun = mnew; lsum *= alpha;
#pragma unroll
        for (int i = 0; i < 16; ++i) { o0[i] *= alpha; o1[i] *= alpha; }
    }
    {
        const f32x2 m2 = {mrun, mrun}; f32x2 acc2 = {0.f, 0.f};
#pragma unroll
        for (int i = 0; i < 16; i += 2) {
            f32x2 a = (f32x2){s0[i], s0[i + 1]} - m2, c = (f32x2){s1[i], s1[i + 1]} - m2;
            a.x = __builtin_amdgcn_exp2f(a.x); a.y = __builtin_amdgcn_exp2f(a.y); c.x = __builtin_amdgcn_exp2f(c.x); c.y = __builtin_amdgcn_exp2f(c.y);
            acc2 = acc2 + a; acc2 = acc2 + c;
            s0[i] = a.x; s0[i + 1] = a.y; s1[i] = c.x; s1[i + 1] = c.y;
        }
        lsum += acc2.x + acc2.y;
    }
    bf16x8 pf[4];
    { u32x4 w;
      w.x = pk2(s0[0], s0[1]); w.y = pk2(s0[2], s0[3]); w.z = pk2(s0[4], s0[5]); w.w = pk2(s0[6], s0[7]); pf[0] = __builtin_bit_cast(bf16x8, w);
      w.x = pk2(s0[8], s0[9]); w.y = pk2(s0[10], s0[11]); w.z = pk2(s0[12], s0[13]); w.w = pk2(s0[14], s0[15]); pf[1] = __builtin_bit_cast(bf16x8, w);
      w.x = pk2(s1[0], s1[1]); w.y = pk2(s1[2], s1[3]); w.z = pk2(s1[4], s1[5]); w.w = pk2(s1[6], s1[7]); pf[2] = __builtin_bit_cast(bf16x8, w);
      w.x = pk2(s1[8], s1[9]); w.y = pk2(s1[10], s1[11]); w.z = pk2(s1[12], s1[13]); w.w = pk2(s1[14], s1[15]); pf[3] = __builtin_bit_cast(bf16x8, w); }
#pragma unroll
    for (int ks = 0; ks < 4; ++ks) { o0 = __builtin_amdgcn_mfma_f32_32x32x16_bf16(va[0][ks], pf[ks], o0, 0, 0, 0); o1 = __builtin_amdgcn_mfma_f32_32x32x16_bf16(va[1][ks], pf[ks], o1, 0, 0, 0); }
}
__device__ __forceinline__ void attn_item(const Params& p, int l, LAS unsigned char* lds, int b, int h, int J) {
    const int tid = opaque_tid(), lane = tid & 63, wave = __builtin_amdgcn_readfirstlane(tid >> 6), r = lane & 31, hf = lane >> 5;
    const bf16_t* Kn = (const bf16_t*)(p.ws + WS_ACT); const bf16_t* Kr = Kn + (size_t)KRPAD * 512;
    const bf16_t* Vt = (const bf16_t*)p.out;
    bf16_t* mix = (bf16_t*)(p.ws + WS_MIX);
    const int i = 8 * J + wave, my_nt = (i >> 1) + 2, blk_nt = 4 * J + 5;
    const int qrow0 = b * TP + NMETA + 32 * i, kbase = b * TP;
    const bf16_t* gkn = Kn + ((size_t)kbase + (tid >> 3)) * 512 + h * 64 + (tid & 7) * 8;
    const bf16_t* gkr = Kr + ((size_t)kbase + ((tid & 255) >> 2)) * 256 + h * 32 + (tid & 3) * 8;
    const bf16_t* gvt = Vt + vt_off(h * 64 + (tid >> 3), kbase + (tid & 7) * 8);
    const int wkn = (tid >> 3) * KROW + (tid & 7) * 16, wkr = ((tid & 255) >> 2) * KROW + 128 + (tid & 3) * 16, wvt = KT_BYTES + (tid >> 3) * VROW + (tid & 7) * 16;
    const int pr = (r & ~12) | ((r & 4) << 1) | ((r & 8) >> 1);
    const int rk = pr * KROW + 16 * hf, rv = KT_BYTES + r * VROW + 16 * hf;
    const bool has_kr = tid < 256;
    u32x4 skn = *(const u32x4*)gkn, svt = *(const u32x4*)gvt, skr = {0u, 0u, 0u, 0u};
    if (has_kr) skr = *(const u32x4*)gkr;
    __builtin_amdgcn_sched_barrier(0);
    bf16x8 qf[6];
    q_prologue(p, l, qrow0 + r, NMETA + 32 * i + r, h, hf, lane, qf);
    *(LAS u32x4*)(lds + wkn) = skn; *(LAS u32x4*)(lds + wvt) = svt; if (has_kr) *(LAS u32x4*)(lds + wkr) = skr;
    __syncthreads();
    f32x16 o0, o1;
#pragma unroll
    for (int q = 0; q < 16; ++q) { o0[q] = 0.f; o1[q] = 0.f; }
    float mrun = -INFINITY, lsum = 0.f;
#pragma nounroll
    for (int j = 0; j < blk_nt; ++j) {
        LAS unsigned char* cur = lds + (j & 1) * ATT_BUF; LAS unsigned char* nxt = lds + ((j + 1) & 1) * ATT_BUF;
        const bool more = (j + 1) < blk_nt;
        if (more) { skn = *(const u32x4*)(gkn + (size_t)(j + 1) * 64 * 512); svt = *(const u32x4*)(gvt + (size_t)(j + 1) * 512 * 64); if (has_kr) skr = *(const u32x4*)(gkr + (size_t)(j + 1) * 64 * 256); }
        if (j < my_nt) {
            bf16x8 ka[2][6], va[2][4];
#pragma unroll
            for (int kb = 0; kb < 2; ++kb)
#pragma unroll
                for (int s = 0; s < 6; ++s) ka[kb][s] = *(const LAS bf16x8*)(cur + rk + kb * 32 * KROW + 32 * s);
#pragma unroll
            for (int dvb = 0; dvb < 2; ++dvb)
#pragma unroll
                for (int ks = 0; ks < 4; ++ks) va[dvb][ks] = *(const LAS bf16x8*)(cur + rv + dvb * 32 * VROW + 32 * ks);
            __builtin_amdgcn_sched_barrier(0);
            if (j < my_nt - 1) attn_step<false>(ka, va, qf, 64, lane, o0, o1, mrun, lsum); else attn_step<true>(ka, va, qf, 16, lane, o0, o1, mrun, lsum);
        }
        if (more) { *(LAS u32x4*)(nxt + wkn) = skn; *(LAS u32x4*)(nxt + wvt) = svt; if (has_kr) *(LAS u32x4*)(nxt + wkr) = skr; }
        __syncthreads();
    }
    lsum += shx32(lsum, lane);
    const float inv = 1.f / lsum;
    bf16_t* op = mix + (size_t)(qrow0 + r) * D + PW + h * DV + 4 * hf;
#pragma unroll
    for (int g = 0; g < 4; ++g) {
        u32x2 w; w.x = pk2(o0[4 * g] * inv, o0[4 * g + 1] * inv); w.y = pk2(o0[4 * g + 2] * inv, o0[4 * g + 3] * inv); *(u32x2*)(op + 8 * g) = w;
        w.x = pk2(o1[4 * g] * inv, o1[4 * g + 1] * inv); w.y = pk2(o1[4 * g + 2] * inv, o1[4 * g + 3] * inv); *(u32x2*)(op + 32 + 8 * g) = w;
    }
}
__device__ __forceinline__ void attn_sample(const Params& p, int l, LAS unsigned char* lds, int b, int h) {
    const int tid = opaque_tid(), lane = tid & 63, wave = __builtin_amdgcn_readfirstlane(tid >> 6), r = lane & 31, hf = lane >> 5;
    const bf16_t* Kn = (const bf16_t*)(p.ws + WS_ACT); const bf16_t* Kr = Kn + (size_t)KRPAD * 512;
    const bf16_t* Vt = (const bf16_t*)p.out;
    bf16_t* mix = (bf16_t*)(p.ws + WS_MIX);
    const int qrow0 = MP + b * DS, kbase = MP + b * SKP;
    bf16x8 qf[6];
    q_prologue(p, l, qrow0 + r, CROWS + r, h, hf, lane, qf);
    const int pr = (r & ~12) | ((r & 4) << 1) | ((r & 8) >> 1);
    const bf16_t* kn0 = Kn + ((size_t)kbase + pr) * 512 + h * 64 + 8 * hf;
    const bf16_t* kr0 = Kr + ((size_t)kbase + pr) * 256 + h * 32 + 8 * hf;
    const bf16_t* vt0 = Vt + vt_off(h * 64 + r, kbase) + 8 * hf;
    f32x16 o0, o1;
#pragma unroll
    for (int q = 0; q < 16; ++q) { o0[q] = 0.f; o1[q] = 0.f; }
    float mrun = -INFINITY, lsum = 0.f;
#pragma nounroll
    for (int j = wave; j < 65; j += 8) {
        const bf16_t* knp = kn0 + (size_t)j * 64 * 512; const bf16_t* krp = kr0 + (size_t)j * 64 * 256; const bf16_t* vtp = vt0 + (size_t)j * 512 * 64;
        bf16x8 ka[2][6], va[2][4];
#pragma unroll
        for (int kb = 0; kb < 2; ++kb) {
#pragma unroll
            for (int s = 0; s < 4; ++s) ka[kb][s] = *(const bf16x8*)(knp + (size_t)kb * 32 * 512 + 16 * s);
#pragma unroll
            for (int s = 0; s < 2; ++s) ka[kb][4 + s] = *(const bf16x8*)(krp + (size_t)kb * 32 * 256 + 16 * s);
        }
#pragma unroll
        for (int dvb = 0; dvb < 2; ++dvb)
#pragma unroll
            for (int ks = 0; ks < 4; ++ks) va[dvb][ks] = *(const bf16x8*)(vtp + (size_t)dvb * 32 * 64 + 16 * ks);
        if (j < 64) attn_step<false>(ka, va, qf, 64, lane, o0, o1, mrun, lsum); else attn_step<true>(ka, va, qf, 48, lane, o0, o1, mrun, lsum);
    }
    lsum += shx32(lsum, lane);
    LAS float* LO = (LAS float*)lds; LAS float* LM = LO + 8 * 32 * 64; LAS float* LL = LM + 8 * 64;
#pragma unroll
    for (int q = 0; q < 16; ++q) { LO[(wave * 32 + q) * 64 + lane] = o0[q]; LO[(wave * 32 + 16 + q) * 64 + lane] = o1[q]; }
    LM[wave * 64 + lane] = mrun; LL[wave * 64 + lane] = lsum;
    __syncthreads();
    float mm = LM[lane];
#pragma unroll
    for (int w = 1; w < 8; ++w) mm = fmaxf(mm, LM[w * 64 + lane]);
    float den = 0.f; float acc4[4] = {0.f, 0.f, 0.f, 0.f};
#pragma unroll
    for (int w = 0; w < 8; ++w) { const float f = __builtin_amdgcn_exp2f(LM[w * 64 + lane] - mm); den += f * LL[w * 64 + lane];
#pragma unroll
        for (int e = 0; e < 4; ++e) acc4[e] += f * LO[(w * 32 + 4 * wave + e) * 64 + lane]; }
    const float inv = 1.f / den;
    bf16_t* op = mix + (size_t)(qrow0 + r) * D + PW + h * DV + 32 * (wave >> 2) + 8 * (wave & 3) + 4 * hf;
    u32x2 wv; wv.x = pk2(acc4[0] * inv, acc4[1] * inv); wv.y = pk2(acc4[2] * inv, acc4[3] * inv); *(u32x2*)op = wv;
    __syncthreads();
}
__device__ __forceinline__ void attn_meta(const Params& p, int l, int b, int h, int qi) {
    const int lane = opaque_tid() & 63;
    const bf16_t* qraw = (const bf16_t*)(p.ws + WS_QRAW);
    const bf16_t* Kn = (const bf16_t*)(p.ws + WS_ACT); const bf16_t* Kr = Kn + (size_t)KRPAD * 512;
    const bf16_t* Vt = (const bf16_t*)p.out;
    bf16_t* mix = (bf16_t*)(p.ws + WS_MIX);
    const float* qn = p.q_norm + (size_t)l * DQK;
    const int row = b * TP + qi, kbase = b * TP;
    const bf16_t* qp = qraw + (size_t)row * 768 + h * DQK;
    float v0 = bflo((unsigned)qp[lane]), v1 = bflo((unsigned)qp[64 + (lane & 31)]);
    {
        float c, s; rope_cs(qi, lane & 15, c, s);
        const float other = shx<16>(v1);
        v1 = (lane & 16) ? (other * s + v1 * c) : (v1 * c - other * s);
    }
    float ss = v0 * v0 + (lane < 32 ? v1 * v1 : 0.f);
    ss = wave_sum(ss, lane);
    const float rs = rsqrtf(ss * (1.f / DQK) + EPS) * 0.14724444602590306f;
    v0 *= rs * qn[lane]; v1 = (lane < 32) ? v1 * rs * qn[64 + (lane & 31)] : 0.f;
    float sc[16]; float mx = -INFINITY;
#pragma unroll
    for (int kk = 0; kk < 16; ++kk) {
        float part = v0 * bflo((unsigned)Kn[((size_t)kbase + kk) * 512 + h * 64 + lane]) + v1 * bflo((unsigned)Kr[((size_t)kbase + kk) * 256 + h * 32 + (lane & 31)]);
        sc[kk] = wave_sum(part, lane); mx = fmaxf(mx, sc[kk]);
    }
    float den = 0.f, acc = 0.f;
    const bf16_t* vp = Vt + vt_off(h * 64 + lane, kbase);
#pragma unroll
    for (int kk = 0; kk < 16; ++kk) { const float pw = __builtin_amdgcn_exp2f(sc[kk] - mx); den += pw; acc += pw * bflo((unsigned)vp[kk]); }
    mix[(size_t)row * D + PW + h * DV + lane] = (bf16_t)(pk2(acc / den, 0.f) & 0xffffu);
}
__device__ __forceinline__ void phase_attn(const Params& p, int l, LAS unsigned char* lds) {
    const int wave = __builtin_amdgcn_readfirstlane(opaque_tid() >> 6), c = blockIdx.x, G = gridDim.x;
    if (G == 256) {
        const int x = c & 7, ci = c >> 3;
        for (int k = 0; k < 8; ++k) { const int bh = 8 * k + x, J = (k & 1) ? 31 - ci : ci; attn_item(p, l, lds, bh >> 3, bh & 7, J); }
    } else {
        for (int k = 0; ; ++k) {
            const int base = k * G; if (base >= 2048) break;
            const int e = (k & 1) ? base + (G - 1 - c) : base + c;
            if (e < 2048) { const int J = 31 - (e >> 6), bh = e & 63; attn_item(p, l, lds, bh >> 3, bh & 7, J); }
        }
    }
    for (int u = c; u < DB * NH; u += G) attn_sample(p, l, lds, u >> 3, u & 7);
    for (int u = c * 8 + wave; u < NB * NH * NMETA; u += G * 8) { const int qi = u & 15, h = (u >> 4) & 7, b = u >> 7; attn_meta(p, l, b, h, qi); }
}

#define XB_TMO      128
#define XB_XCNT(j)  (256  + 64 * (j))
#define XB_XSUB(j)  (1280 + 64 * (j))
#define XB_XGEN(j)  (2304 + 64 * (j))
#define XB_TOP      3328
#define XB_TOPGEN   3392
#define XCD_BAR_WORDS 3456
#define XB_SPIN_CAP (1u << 20)
__device__ __forceinline__ unsigned xb_ld(unsigned* p)              { return __hip_atomic_load(p, __ATOMIC_RELAXED, __HIP_MEMORY_SCOPE_AGENT); }
__device__ __forceinline__ unsigned xb_add(unsigned* p, unsigned v) { return __hip_atomic_fetch_add(p, v, __ATOMIC_RELAXED, __HIP_MEMORY_SCOPE_AGENT); }
__device__ __forceinline__ unsigned xb_xcc_id() { return (unsigned)__builtin_amdgcn_s_getreg((3 << 11) | 20) & 0xFu; }
#define XB_SPIN(cond, bar) do { unsigned _sp = 0; while (cond) { __builtin_amdgcn_s_sleep(1); \
    if ((++_sp & 255u) == 0u) { if (xb_ld(&(bar)[XB_TMO])) break; if (_sp > XB_SPIN_CAP) { atomicAdd(&(bar)[XB_TMO], 1u); break; } } } } while (0)
struct XcdBarrier { unsigned* bar; unsigned x; volatile LAS unsigned* st; };
__device__ __forceinline__ XcdBarrier xcd_barrier_post(unsigned* bar, volatile LAS unsigned* st) {
    XcdBarrier b; b.bar = bar; b.x = xb_xcc_id(); b.st = st;
    if (threadIdx.x == 0) (void)xb_add(&bar[XB_XCNT(b.x)], 1u);
    return b;
}
__device__ __forceinline__ void xcd_barrier_complete(unsigned* bar, unsigned x, unsigned& nloc, unsigned& nx) {
    const unsigned G = gridDim.x * gridDim.y * gridDim.z;
    unsigned sum, cnt, mine, sp = 0u;
    for (;;) {
        sum = 0u; cnt = 0u; mine = 0u;
#pragma unroll
        for (unsigned j = 0; j < 16; ++j) { const unsigned c = xb_ld(&bar[XB_XCNT(j)]); sum += c; cnt += (c > 0u) ? 1u : 0u; mine = (j == x) ? c : mine; }
        if (sum == G) break;
        __builtin_amdgcn_s_sleep(1);
        if ((++sp & 255u) == 0u) { if (xb_ld(&bar[XB_TMO])) break; if (sp > XB_SPIN_CAP) { atomicAdd(&bar[XB_TMO], 1u); break; } }
    }
    nloc = mine > 0u ? mine : 1u; nx = cnt > 0u ? cnt : 1u;
}
__device__ __forceinline__ void xcd_barrier(const XcdBarrier& b) {
    asm volatile("s_waitcnt vmcnt(0)" ::: "memory");
    __syncthreads();
    if (threadIdx.x == 0) {
        unsigned* bar = b.bar;
        __builtin_amdgcn_s_waitcnt(0);
        unsigned nloc = b.st[0], nx = b.st[1];
        if (nloc == 0u) { xcd_barrier_complete(bar, b.x, nloc, nx); b.st[0] = nloc; b.st[1] = nx; }
        const unsigned old = xb_add(&bar[XB_XSUB(b.x)], 1u);
        const unsigned gen = old / nloc;
        if (old + 1u == (gen + 1u) * nloc) {
            __builtin_amdgcn_fence(__ATOMIC_RELEASE, "agent");
            asm volatile("s_waitcnt vmcnt(0)" ::: "memory");
            const unsigned og = xb_add(&bar[XB_TOP], 1u);
            const unsigned tg = og / nx;
            if (og + 1u == (tg + 1u) * nx) xb_add(&bar[XB_TOPGEN], 1u);
            else XB_SPIN(xb_ld(&bar[XB_TOPGEN]) == tg, bar);
            __builtin_amdgcn_fence(__ATOMIC_ACQUIRE, "agent");
            xb_add(&bar[XB_XGEN(b.x)], 1u);
            asm volatile("s_waitcnt vmcnt(0)" ::: "memory");
        } else {
            XB_SPIN(xb_ld(&bar[XB_XGEN(b.x)]) == gen, bar);
            __builtin_amdgcn_fence(__ATOMIC_ACQUIRE, "agent");
            asm volatile("s_waitcnt vmcnt(0)" ::: "memory");
        }
    }
    __syncthreads();
}

__global__ void __launch_bounds__(512, 2) fwd_mega(Params p0) {
    extern __shared__ __attribute__((aligned(16))) unsigned char shm[];
    LAS unsigned char* lds = (LAS unsigned char*)shm;
    cg::grid_group grid = cg::this_grid();
    volatile LAS unsigned* xst = (volatile LAS unsigned*)(lds + pg8::STAGE_BYTES);
    if (threadIdx.x == 0) { xst[0] = 0u; xst[1] = 0u; }
    __syncthreads();
    const XcdBarrier xb = xcd_barrier_post((unsigned*)(p0.ws + WS_BAR), xst);
    phase_prep(p0, lds, 0, 0x9f, (int)blockIdx.x, (int)gridDim.x);
#pragma nounroll
    for (int li = 0; li < 2; ++li) {
        Params p = p0; int l = li;
        { size_t zw = 0, zo = 0; asm volatile("" : "+s"(zw), "+s"(zo), "+s"(l)); p.ws = p0.ws + zw; p.out = p0.out + zo; }
        bf16_t* wts = (bf16_t*)(p.ws + WS_WTS);
        bf16_t* xrb = (bf16_t*)(p.ws + WS_XRES);
        bf16_t* hbuf = (bf16_t*)(p.ws + WS_HBUF);
        bf16_t* mix = (bf16_t*)(p.ws + WS_MIX);
        bf16_t* act = (bf16_t*)(p.ws + WS_ACT);
        bf16_t* qraw = (bf16_t*)(p.ws + WS_QRAW);
        bf16_t* Kn = act;
        bf16_t* Vt = (bf16_t*)p.out;
        bf16_t* qa = Vt + (size_t)KRPAD * 512;
        const bf16_t* wl = wts + (size_t)l * W_LAYER;
        float* slot = (float*)(p.ws + WS_SLOT); const float* rs = (const float*)(p.ws + WS_RS);
        if (l == 0) { phase_rmsnorm_first(p); grid.sync(); }
        run_gemm(lds, xrb, wl + W_IN, MPAD, DINP, D, pg8::EpiBf16S<DINP>{act, rs}, 0);
        if (l == 0) {
            const int G = gridDim.x, extra = ((MPAD / 256) * (DINP / 256)) % G, c = blockIdx.x;
            if (c >= extra) phase_cacheconv(p, 0, c - extra, G - extra);
        }
        xcd_barrier(xb);
        phase_postin(p, l);
        xcd_barrier(xb);
        run_gemm(lds, qa, wl + W_UQ, MPAD, 768, QRK, pg8::EpiBf16<768>{qraw}, 0);
        run_gemm(lds, hbuf, wl + W_UK, KRPAD, 512, KVR, EpiKnorm{p, l}, 256 - 15);
        run_gemm(lds, wl + W_UV, hbuf, 512, KRPAD, KVR, pg8::EpiVt{Vt}, 256 - 33);
        xcd_barrier(xb);
        phase_attn(p, l, lds);
        xcd_barrier(xb);
        if (l == 0) run_gemm(lds, mix, wl + W_O, MPAD, D, D, pg8::EpiResInitB{xrb, p.meta, p.x_prompt, p.x_sample, slot}, 0);
        else run_gemm(lds, mix, wl + W_O, MPAD, D, D, pg8::EpiResAddB{xrb, slot}, 0);
        if (l == 0) { int G = gridDim.x, c = blockIdx.x; asm volatile("" : "+s"(G), "+s"(c));
            const int extra = ((MPAD / 256) * (D / 256)) % G; if (c >= extra) phase_prep(p, lds, 0, 0x20, c - extra, G - extra); }
        xcd_barrier(xb);
        phase_rowstat(p);
        xcd_barrier(xb);
        run_gemm(lds, xrb, wl + W_GU, MPAD, 2 * DFF, D, pg8::EpiSwiglu{act, rs}, 0);
        if (l == 0) { int G = gridDim.x, c = blockIdx.x; asm volatile("" : "+s"(G), "+s"(c));
            const int extra = ((MPAD / 256) * (2 * DFF / 256)) % G; if (c >= extra) phase_prep(p, lds, 0, 0x40, c - extra, G - extra); }
        xcd_barrier(xb);
        if (l == 0) {
            run_gemm(lds, act, wl + W_DN, MPAD, D, DFF, pg8::EpiResAddB{xrb, slot}, 0);
            { int G = gridDim.x, c = blockIdx.x; asm volatile("" : "+s"(G), "+s"(c));
              const int extra = ((MPAD / 256) * (D / 256)) % G; if (c >= extra) { phase_cacheconv(p, 1, c - extra, G - extra); phase_prep(p, lds, 1, 0xff, c - extra, G - extra); } }
            xcd_barrier(xb); phase_rowstat(p); xcd_barrier(xb); }
        else { run_gemm(lds, act, wl + W_DN, MPAD, D, DFF, pg8::EpiFinalB{xrb, p.out}, 0); xcd_barrier(xb); }
    }
}

extern "C" void kernel_launch(void* const* d_in, const int* in_sizes, int n_in, void* d_out, int out_size, void* d_ws, size_t ws_size, hipStream_t stream) {
    constexpr int LDS_BYTES = pg8::STAGE_BYTES + 16;
    static int grid = 0;
    if (grid == 0) {
        if (n_in != 22 || (size_t)out_size != O_END || ws_size < WS_TOTAL) { fprintf(stderr, "kernel_launch: unexpected sizes n_in %d out %d ws %zu (need %zu)\n", n_in, out_size, ws_size, (size_t)WS_TOTAL); grid = -1; return; }
        int dev = 0, cus = 0, per_cu = 0;
        if (hipGetDevice(&dev) != hipSuccess || hipDeviceGetAttribute(&cus, hipDeviceAttributeMultiprocessorCount, dev) != hipSuccess) { grid = -1; return; }
        if (hipFuncSetAttribute((const void*)fwd_mega, hipFuncAttributeMaxDynamicSharedMemorySize, LDS_BYTES) != hipSuccess) { fprintf(stderr, "hipFuncSetAttribute failed\n"); grid = -1; return; }
        if (hipOccupancyMaxActiveBlocksPerMultiprocessor(&per_cu, (const void*)fwd_mega, 512, LDS_BYTES) != hipSuccess || per_cu < 1) fprintf(stderr, "occupancy query: %d\n", per_cu);
        (void)hipGetLastError();
        grid = cus;
    }
    if (grid < 0) return;
    if (hipMemsetAsync((char*)d_ws + WS_BAR, 0, 3456 * 4, stream) != hipSuccess) { fprintf(stderr, "memset of barrier words failed\n"); return; }
    Params p{};
    const float** f = (const float**)&p;
    for (int i = 0; i < 22; ++i) f[i] = (const float*)d_in[i];
    p.out = (float*)d_out; p.ws = (unsigned char*)d_ws;
    void* args[] = {&p};
    hipError_t e = hipLaunchCooperativeKernel((void*)fwd_mega, dim3(grid), dim3(512), args, LDS_BYTES, stream);
    if (e != hipSuccess) fprintf(stderr, "cooperative launch failed: %s (grid %d)\n", hipGetErrorString(e), grid);
}
```
